# Optimizing an MI355X kernel written in HIP

```python
import jax, jax.numpy as jnp
from jax import lax
import numpy as np

D_MODEL = 1024
BATCH = 8
SEQ = 4096
DEPTH = 4

CHUNK = 64
Q_BLOCK = 128
PLE_DIM = 256

MLA_HEADS = 16
MLA_Q_LORA = D_MODEL // 2
MLA_KV_LORA = D_MODEL // 4
MLA_NOPE = 128
MLA_ROPE = 64
MLA_V = 128
ROPE_THETA = 10000.0

GLA_HEADS = 4
GLA_QK = D_MODEL // 2
GLA_VD = D_MODEL
GLA_DK = GLA_QK // GLA_HEADS
GLA_DV = GLA_VD // GLA_HEADS
GLA_GATE_RANK = 16
GLA_TAU = 16.0

D_FF = 2816
CONV_W = 3

N_MLA = (DEPTH + 1) // 2
N_GLA = DEPTH // 2
DN_ALPHA = (2 * DEPTH) ** 0.25
DN_BETA = (8 * DEPTH) ** -0.25
EPS = 1e-5
NEG_INF = -1e30

kernel_name = "hybrid_mla_gla_deepnorm_convffn_ple"


def layer_norm(x, g, b):
    xf = x.astype(jnp.float32)
    mu = jnp.mean(xf, -1, keepdims=True)
    var = jnp.mean(jnp.square(xf - mu), -1, keepdims=True)
    return ((xf - mu) * lax.rsqrt(var + EPS) * g + b).astype(x.dtype)


def rms_norm(x, g):
    xf = x.astype(jnp.float32)
    return (xf * lax.rsqrt(jnp.mean(jnp.square(xf), -1, keepdims=True) + EPS) * g).astype(x.dtype)


def rope_tables(positions):
    inv = 1.0 / (ROPE_THETA ** (jnp.arange(0, MLA_ROPE, 2, dtype=jnp.float32) / MLA_ROPE))
    ang = positions.astype(jnp.float32)[..., None] * inv
    return jnp.cos(ang), jnp.sin(ang)


def apply_rope(x, cos, sin):
    x1, x2 = jnp.split(x, 2, axis=-1)
    c = cos.astype(x.dtype)
    s = sin.astype(x.dtype)
    return jnp.concatenate([x1 * c - x2 * s, x1 * s + x2 * c], axis=-1)


def mla_mixer(x, positions, cos, sin, w_in, q_norm, kv_norm, w_uq, w_uk, w_uv, w_o):
    B, S, _ = x.shape
    h = x @ w_in
    c_q, c_kv, k_r = jnp.split(h, [MLA_Q_LORA, MLA_Q_LORA + MLA_KV_LORA], axis=-1)
    c_q = rms_norm(c_q, q_norm)
    c_kv = rms_norm(c_kv, kv_norm)
    q = (c_q @ w_uq).reshape(B, S, MLA_HEADS, MLA_NOPE + MLA_ROPE)
    q_nope = q[..., :MLA_NOPE]
    q_rope = apply_rope(q[..., MLA_NOPE:], cos[:, :, None], sin[:, :, None])
    k_rope = apply_rope(k_r, cos, sin)
    k_nope = (c_kv @ w_uk).reshape(B, S, MLA_HEADS, MLA_NOPE)
    v = (c_kv @ w_uv).reshape(B, S, MLA_HEADS, MLA_V)
    scale = (MLA_NOPE + MLA_ROPE) ** -0.5
    chunk_id = positions // CHUNK
    outs = []
    for blk in range(S // Q_BLOCK):
        q0 = blk * Q_BLOCK
        q1 = q0 + Q_BLOCK
        s = (jnp.einsum('bqhd,bkhd->bhqk', q_nope[:, q0:q1], k_nope[:, :q1])
             + jnp.einsum('bqhr,bkr->bhqk', q_rope[:, q0:q1], k_rope[:, :q1])).astype(jnp.float32) * scale
        mask = chunk_id[:, None, :q1] <= chunk_id[:, q0:q1, None]
        s = jnp.where(mask[:, None], s, NEG_INF)
        pr = jax.nn.softmax(s, axis=-1).astype(v.dtype)
        outs.append(jnp.einsum('bhqk,bkhd->bqhd', pr, v[:, :q1]))
    o = jnp.concatenate(outs, axis=1).reshape(B, S, MLA_HEADS * MLA_V)
    return (o @ w_o).astype(x.dtype)


def gla_mixer(x, w_in, w_a2, b_a, o_norm, w_o):
    B, S, _ = x.shape
    N = S // CHUNK
    h = x @ w_in
    q, k, v, r, a = jnp.split(h, [GLA_QK, 2 * GLA_QK, 2 * GLA_QK + GLA_VD, 2 * GLA_QK + 2 * GLA_VD], axis=-1)
    log_a = jax.nn.log_sigmoid((a @ w_a2 + b_a).astype(jnp.float32)) / GLA_TAU
    q = q.reshape(B, N, CHUNK, GLA_HEADS, GLA_DK) * (GLA_DK ** -0.5)
    k = k.reshape(B, N, CHUNK, GLA_HEADS, GLA_DK)
    v = v.reshape(B, N, CHUNK, GLA_HEADS, GLA_DV)
    log_a = log_a.reshape(B, N, CHUNK, GLA_HEADS, GLA_DK)
    cum = jnp.cumsum(log_a, axis=2)
    tot = cum[:, :, -1]
    k_dec = k * jnp.exp(tot[:, :, None] - cum).astype(k.dtype)
    upd = jnp.einsum('bnchk,bnchv->nbhkv', k_dec, v).astype(jnp.float32)
    decay = jnp.exp(jnp.moveaxis(tot, 1, 0))
    q_n = jnp.moveaxis(q, 1, 0)

    def step(state, inp):
        g, u, qc = inp
        state = state * g[..., None] + u
        return state, jnp.einsum('bchk,bhkv->bchv', qc, state)

    state0 = jnp.zeros((B, GLA_HEADS, GLA_DK, GLA_DV), jnp.float32)
    _, o = lax.scan(step, state0, (decay, upd, q_n))
    o = jnp.moveaxis(o, 0, 1).reshape(B, S, GLA_HEADS, GLA_DV)
    mu = jnp.mean(o, -1, keepdims=True)
    var = jnp.mean(jnp.square(o - mu), -1, keepdims=True)
    o = (o - mu) * lax.rsqrt(var + EPS) * o_norm.reshape(GLA_HEADS, GLA_DV)
    o = o.reshape(B, S, GLA_VD).astype(x.dtype) * jax.nn.silu(r)
    return (o @ w_o).astype(x.dtype)


def conv_ffn(x, w_up, conv_w, conv_b, w_down):
    S = x.shape[1]
    h = x @ w_up
    hp = jnp.pad(h, ((0, 0), (CONV_W - 1, 0), (0, 0)))
    h = hp[:, 0:S] * conv_w[0] + hp[:, 1:S + 1] * conv_w[1] + hp[:, 2:S + 2] * conv_w[2] + conv_b
    u, g = jnp.split(h, 2, axis=-1)
    return ((u * jax.nn.gelu(g)) @ w_down).astype(x.dtype)


def setup_inputs(seed: int = 0) -> dict:
    key = jax.random.key(seed)
    ks = iter(jax.random.split(key, 40))
    f32 = jnp.float32

    def nrm(shape, scale):
        return jax.random.normal(next(ks), shape, f32) * scale

    def gain(shape):
        return 1.0 + nrm(shape, 0.01)

    x = jax.random.normal(next(ks), (BATCH, SEQ, D_MODEL), f32)
    p = jax.random.normal(next(ks), (DEPTH, BATCH, SEQ, PLE_DIM), f32)
    offsets = jax.random.randint(next(ks), (BATCH, 1), 0, 16, dtype=jnp.int32) * CHUNK
    positions = (jnp.arange(SEQ, dtype=jnp.int32)[None, :] + offsets).astype(jnp.int32)

    mla_in = MLA_Q_LORA + MLA_KV_LORA + MLA_ROPE
    gla_in = 2 * GLA_QK + 2 * GLA_VD + GLA_GATE_RANK
    return {
        "x": x,
        "p": p,
        "positions": positions,
        "mla_w_in": nrm((N_MLA, D_MODEL, mla_in), D_MODEL ** -0.5),
        "mla_q_norm": gain((N_MLA, MLA_Q_LORA)),
        "mla_kv_norm": gain((N_MLA, MLA_KV_LORA)),
        "mla_w_uq": nrm((N_MLA, MLA_Q_LORA, MLA_HEADS * (MLA_NOPE + MLA_ROPE)), MLA_Q_LORA ** -0.5),
        "mla_w_uk": nrm((N_MLA, MLA_KV_LORA, MLA_HEADS * MLA_NOPE), MLA_KV_LORA ** -0.5),
        "mla_w_uv": nrm((N_MLA, MLA_KV_LORA, MLA_HEADS * MLA_V), DN_BETA * MLA_KV_LORA ** -0.5),
        "mla_w_o": nrm((N_MLA, MLA_HEADS * MLA_V, D_MODEL), DN_BETA * (MLA_HEADS * MLA_V) ** -0.5),
        "gla_w_in": nrm((N_GLA, D_MODEL, gla_in), D_MODEL ** -0.5),
        "gla_w_a2": nrm((N_GLA, GLA_GATE_RANK, GLA_QK), GLA_GATE_RANK ** -0.5),
        "gla_b_a": nrm((N_GLA, GLA_QK), 0.1),
        "gla_o_norm": gain((N_GLA, GLA_VD)),
        "gla_w_o": nrm((N_GLA, GLA_VD, D_MODEL), DN_BETA * GLA_VD ** -0.5),
        "ln1_g": gain((DEPTH, D_MODEL)),
        "ln1_b": nrm((DEPTH, D_MODEL), 0.01),
        "ln2_g": gain((DEPTH, D_MODEL)),
        "ln2_b": nrm((DEPTH, D_MODEL), 0.01),
        "ffn_w_up": nrm((DEPTH, D_MODEL, 2 * D_FF), D_MODEL ** -0.5),
        "ffn_conv_w": nrm((DEPTH, CONV_W, 2 * D_FF), CONV_W ** -0.5),
        "ffn_conv_b": nrm((DEPTH, 2 * D_FF), 0.01),
        "ffn_w_down": nrm((DEPTH, D_FF, D_MODEL), DN_BETA * D_FF ** -0.5),
        "ple_w_proj": nrm((DEPTH, PLE_DIM, D_MODEL), PLE_DIM ** -0.5),
        "ple_w_gate": nrm((DEPTH, D_MODEL, D_MODEL), D_MODEL ** -0.5),
        "ple_b_gate": nrm((DEPTH, D_MODEL), 0.01),
    }


def reference(x, p, positions, mla_w_in, mla_q_norm, mla_kv_norm, mla_w_uq, mla_w_uk, mla_w_uv, mla_w_o,
              gla_w_in, gla_w_a2, gla_b_a, gla_o_norm, gla_w_o, ln1_g, ln1_b, ln2_g, ln2_b,
              ffn_w_up, ffn_conv_w, ffn_conv_b, ffn_w_down, ple_w_proj, ple_w_gate, ple_b_gate):
    cos, sin = rope_tables(positions)
    for i in range(DEPTH):
        j = i // 2
        if i % 2 == 0:
            m = mla_mixer(x, positions, cos, sin, mla_w_in[j], mla_q_norm[j], mla_kv_norm[j],
                          mla_w_uq[j], mla_w_uk[j], mla_w_uv[j], mla_w_o[j])
        else:
            m = gla_mixer(x, gla_w_in[j], gla_w_a2[j], gla_b_a[j], gla_o_norm[j], gla_w_o[j])
        x = layer_norm(DN_ALPHA * x + m, ln1_g[i], ln1_b[i])
        x = layer_norm(DN_ALPHA * x + conv_ffn(x, ffn_w_up[i], ffn_conv_w[i], ffn_conv_b[i], ffn_w_down[i]),
                       ln2_g[i], ln2_b[i])
        gate = jax.nn.sigmoid(x @ ple_w_gate[i] + ple_b_gate[i])
        x = x + gate * (p[i] @ ple_w_proj[i])
    return x
```

```cpp
#include <hip/hip_runtime.h>
#include <hip/hip_cooperative_groups.h>
#include <cstdio>
#include <cmath>
#include <type_traits>
namespace cg = cooperative_groups;

#ifndef MULTI_LAUNCH
#define MULTI_LAUNCH 0
#endif
#ifndef PROBE_MASK
#define PROBE_MASK 0
#endif

#define DI __device__ __forceinline__
typedef unsigned short bf16_t;
typedef short bf16x8 __attribute__((ext_vector_type(8)));
typedef float f32x16 __attribute__((ext_vector_type(16)));
typedef float f32x4 __attribute__((ext_vector_type(4)));
typedef float f32x2 __attribute__((ext_vector_type(2)));
typedef unsigned u32x4 __attribute__((ext_vector_type(4)));
typedef unsigned u32x2 __attribute__((ext_vector_type(2)));
typedef int i32x4 __attribute__((ext_vector_type(4)));
typedef __bf16 bf16x2_t __attribute__((ext_vector_type(2)));

#define MFMA32(a, b, c) __builtin_amdgcn_mfma_f32_32x32x16_bf16((a), (b), (c), 0, 0, 0)
#define MFMA16(a, b, c) __builtin_amdgcn_mfma_f32_16x16x32_bf16((a), (b), (c), 0, 0, 0)

DI unsigned pk2(float lo, float hi) { f32x2 v = {lo, hi}; return __builtin_bit_cast(unsigned, __builtin_convertvector(v, bf16x2_t)); }
DI bf16_t f2bf(float x) { return (bf16_t)(pk2(x, 0.f) & 0xffffu); }
DI float bf2f(unsigned x) { return __uint_as_float(x << 16); }
DI u32x2 pk4(float a, float b, float c, float d) { u32x2 r; r.x = pk2(a, b); r.y = pk2(c, d); return r; }
DI float fexp2(float x) { return __builtin_amdgcn_exp2f(x); }
DI float frcp(float x) { return __builtin_amdgcn_rcpf(x); }
DI float sigmoidf_(float x) { return frcp(1.f + fexp2(-1.44269504089f * x)); }
DI float gelu_tanh(float x) { const float t = __builtin_fmaf(x * x, -0.10294324f, -2.30220820f); return x * frcp(1.f + fexp2(t * x)); }

constexpr int TT = 32768, SS = 4096, DM = 1024;
constexpr int NTH = 512;
constexpr float DN_ALPHA = 1.6817928305074292f;
constexpr float EPS = 1e-5f;
constexpr int DFF = 2816;
constexpr int HALF_T = TT / 2;

constexpr size_t MiB = 1u << 20;
constexpr size_t OFF_WB = 0;
constexpr size_t OFF_COS = 116 * MiB, OFF_SIN = 120 * MiB, OFF_SSQ = 124 * MiB, OFF_KROPE = 126 * MiB, OFF_GA = 130 * MiB;
constexpr size_t OFF_CID = 132 * MiB, OFF_TMIN = OFF_CID + 256 * 1024, OFF_TMAX = OFF_TMIN + 4096;
constexpr size_t OFF_STATS = 133 * MiB;
constexpr size_t OFF_BAR = 134 * MiB;
constexpr size_t OFF_XB = 136 * MiB;
constexpr size_t OFF_H = 200 * MiB, OFF_Q = 248 * MiB, OFF_KN = 344 * MiB, OFF_VT = 408 * MiB;
constexpr size_t OFF_ST = 136 * MiB, OFF_GQ = 264 * MiB, OFF_GK = 296 * MiB, OFF_GVT = 328 * MiB, OFF_OG = 328 * MiB, OFF_GR = 392 * MiB;
constexpr size_t OFF_GATED = 200 * MiB;
constexpr size_t OFF_XBN_A = 200 * MiB, OFF_XBN_B = 392 * MiB;
constexpr size_t WS_NEED = 472 * MiB;

constexpr size_t W_MLA_IN = 0, W_MLA_UQ = W_MLA_IN + 896 * 1024, W_MLA_KV = W_MLA_UQ + 3072 * 512, W_MLA_O = W_MLA_KV + 4096 * 256, W_MLA_SZ = W_MLA_O + 1024 * 2048;
constexpr size_t W_GLA_IN = 0, W_GLA_O = W_GLA_IN + 3328 * 1024, W_GLA_SZ = W_GLA_O + 1024 * 1024;
constexpr size_t W_FFN_UP = 0, W_FFN_DN = W_FFN_UP + 5632 * 1024, W_FFN_SZ = W_FFN_DN + 1024 * 2816;
constexpr size_t W_PLE_G = 0, W_PLE_P = W_PLE_G + 1024 * 1024, W_PLE_SZ = W_PLE_P + 1024 * 256;
constexpr size_t WB_MLA = 0, WB_GLA = WB_MLA + 2 * W_MLA_SZ, WB_FFN = WB_GLA + 2 * W_GLA_SZ, WB_PLE = WB_FFN + 4 * W_FFN_SZ, WB_END = WB_PLE + 4 * W_PLE_SZ;
static_assert(WB_END * 2 <= 116 * MiB, "weight arena");

constexpr int G_STAGE = 49152, G_BOFF = 32768, XCH_OFF = 3 * G_STAGE, LDS_BYTES = XCH_OFF + 4096;
constexpr int AT_KB = 24576, AT_STAGE = 40960;

struct Params {
    const float* x; const float* p; const int* pos;
    const float *mla_w_in, *mla_q_norm, *mla_kv_norm, *mla_w_uq, *mla_w_uk, *mla_w_uv, *mla_w_o;
    const float *gla_w_in, *gla_w_a2, *gla_b_a, *gla_o_norm, *gla_w_o;
    const float *ln1_g, *ln1_b, *ln2_g, *ln2_b;
    const float *ffn_w_up, *ffn_conv_w, *ffn_conv_b, *ffn_w_down;
    const float *ple_w_proj, *ple_w_gate, *ple_b_gate;
    float* out; char* ws;
    double invrev[32];
    int ph_lo, ph_hi, dry, pad_;
};

extern __shared__ __attribute__((aligned(16))) char smem[];

template <bool AF32> struct AReg { u32x4 v[AF32 ? 8 : 4]; };
#define RAW_BARRIER() do { asm volatile("s_waitcnt lgkmcnt(0)" ::: "memory"); __builtin_amdgcn_s_barrier(); } while (0)

template <bool AF32, int AMODE, bool SWAP>
DI void mainloop_rs(f32x16 (&acc)[2][2], const void* Abase, int lda, int arow0, int amax, const bf16_t* Bbase, int ldb, int brow0, int nk, int tid) {
    const int l = tid & 63, w = tid >> 6, wr = w >> 1, wc = w & 1, h = l >> 5, li = l & 31;
    const int lc = tid & 7, lr = tid >> 3;
    const int st_off = lr * 128 + ((lc ^ ((lr >> 1) & 7)) << 4);
    const int lk = h ^ ((l >> 1) & 7);
    const int a_off = (wr * 64 + li) * 128, b_off = G_BOFF + (wc * 64 + li) * 128;
#pragma unroll
    for (int mi = 0; mi < 2; ++mi)
#pragma unroll
        for (int ni = 0; ni < 2; ++ni)
#pragma unroll
            for (int r = 0; r < 16; ++r) acc[mi][ni][r] = 0.f;
    AReg<AF32> ra; u32x4 rb[2];
    long arow[4];
#pragma unroll
    for (int i = 0; i < 4; ++i) { int row = arow0 + lr + 64 * i; row = row < 0 ? 0 : (row > amax ? amax : row); arow[i] = (long)row * lda + lc * 8; }
    const bf16_t* bp = Bbase + (long)(brow0 + lr) * ldb + lc * 8;
    auto gload = [&](int kt) {
        const int ka = (AMODE == 1) ? ((kt >> 1) * 192 + (kt & 1) * 64) : kt * 64;
#pragma unroll
        for (int i = 0; i < 4; ++i) {
            if (!AF32) ra.v[i] = *(const u32x4*)((const bf16_t*)Abase + arow[i] + ka);
            else { const float* p = (const float*)Abase + arow[i] + ka; ra.v[2 * i] = *(const u32x4*)p; ra.v[2 * i + 1] = *(const u32x4*)(p + 4); }
        }
#pragma unroll
        for (int i = 0; i < 2; ++i) rb[i] = *(const u32x4*)(bp + (long)(64 * i) * ldb + kt * 64);
    };
    auto lstore = [&](int s) {
        char* sb = smem + s * G_STAGE;
#pragma unroll
        for (int i = 0; i < 4; ++i) {
            u32x4 v;
            if (!AF32) v = ra.v[i];
            else { const u32x4 a = ra.v[2 * i], b = ra.v[2 * i + 1];
                v.x = pk2(__uint_as_float(a.x), __uint_as_float(a.y)); v.y = pk2(__uint_as_float(a.z), __uint_as_float(a.w));
                v.z = pk2(__uint_as_float(b.x), __uint_as_float(b.y)); v.w = pk2(__uint_as_float(b.z), __uint_as_float(b.w)); }
            *(u32x4*)(sb + st_off + i * 8192) = v;
        }
#pragma unroll
        for (int i = 0; i < 2; ++i) *(u32x4*)(sb + G_BOFF + st_off + i * 8192) = rb[i];
    };
    __syncthreads();
    gload(0); lstore(0); __syncthreads();
    for (int kt = 0; kt < nk; ++kt) {
        const bool more = kt + 1 < nk;
        if (more) gload(kt + 1);
        const char* sb = smem + (kt & 1) * G_STAGE;
#pragma unroll
        for (int ks = 0; ks < 4; ++ks) {
            const int co = (lk ^ (2 * ks)) << 4;
            bf16x8 a0 = *(const bf16x8*)(sb + a_off + co), a1 = *(const bf16x8*)(sb + a_off + 4096 + co);
            bf16x8 b0 = *(const bf16x8*)(sb + b_off + co), b1 = *(const bf16x8*)(sb + b_off + 4096 + co);
            if (!SWAP) { acc[0][0] = MFMA32(a0, b0, acc[0][0]); acc[0][1] = MFMA32(a0, b1, acc[0][1]); acc[1][0] = MFMA32(a1, b0, acc[1][0]); acc[1][1] = MFMA32(a1, b1, acc[1][1]); }
            else { acc[0][0] = MFMA32(b0, a0, acc[0][0]); acc[0][1] = MFMA32(b1, a0, acc[0][1]); acc[1][0] = MFMA32(b0, a1, acc[1][0]); acc[1][1] = MFMA32(b1, a1, acc[1][1]); }
        }
        if (more) lstore((kt + 1) & 1);
        __syncthreads();
    }
}

template <int MI> struct Cfg { static constexpr int NWC = (MI == 2 ? 2 : 4), BN = 64 * NWC, WROWS = 32 * MI, STAGE = (256 + BN) * 128, NBI = BN / 64; };
struct TD { const bf16_t* A; const bf16_t* B; int lda, ldb, arow0, amax, brow0, nk; };
DI TD mk_td(const bf16_t* A, int lda, int arow0, int amax, const bf16_t* B, int ldb, int brow0, int nk) { TD t; t.A = A; t.B = B; t.lda = lda; t.ldb = ldb; t.arow0 = arow0; t.amax = amax; t.brow0 = brow0; t.nk = nk; return t; }

template <int AMODE, bool SWAP, int MI>
DI void mainloop_dma(f32x16 (&acc)[MI][2], const TD& c, const TD& n, bool hasn, bool primed, int& s, int tid) {
    typedef Cfg<MI> C;
    const int l = tid & 63, w = tid >> 6, wr = w / C::NWC, wc = w % C::NWC, h = l >> 5, li = l & 31;
    const int lk = h ^ ((l >> 1) & 7);
    const int a_off = (wr * C::WROWS + li) * 128, b_off = G_BOFF + (wc * 64 + li) * 128;
    constexpr int NST = (MI == 2 ? 3 : 2);
#pragma unroll
    for (int mi = 0; mi < MI; ++mi)
#pragma unroll
        for (int ni = 0; ni < 2; ++ni)
#pragma unroll
            for (int r = 0; r < 16; ++r) acc[mi][ni][r] = 0.f;
    constexpr int NP = 4 + C::NBI;
    auto offs = [&](const TD& t, int (&ao)[4], int (&bo)[C::NBI]) {
#pragma unroll
        for (int i = 0; i < 4; ++i) {
            int row = t.arow0 + (4 * w + i) * 8 + (l >> 3); row = row < 0 ? 0 : (row > t.amax ? t.amax : row);
            ao[i] = row * t.lda + ((l & 7) ^ (((l >> 4) + 4 * (i & 1)) & 7)) * 8;
        }
#pragma unroll
        for (int i = 0; i < C::NBI; ++i) {
            const int row = t.brow0 + (C::NBI * w + i) * 8 + (l >> 3);
            bo[i] = row * t.ldb + ((l & 7) ^ (((l >> 4) + 4 * (i & 1)) & 7)) * 8;
        }
    };
    auto piece = [&](const TD& t, const int (&ao)[4], const int (&bo)[C::NBI], int kt, int st, int i) {
        char* sb = smem + st * C::STAGE;
        if (i < 4) {
            const int ka = (AMODE == 1) ? ((kt >> 1) * 192 + (kt & 1) * 64) : kt * 64;
            __builtin_amdgcn_global_load_lds((const __attribute__((address_space(1))) void*)(t.A + ka + ao[i]), (__attribute__((address_space(3))) void*)(sb + (4 * w + i) * 1024), 16, 0, 0);
        } else {
            __builtin_amdgcn_global_load_lds((const __attribute__((address_space(1))) void*)(t.B + kt * 64 + bo[i - 4]), (__attribute__((address_space(3))) void*)(sb + G_BOFF + (C::NBI * w + i - 4) * 1024), 16, 0, 0);
        }
    };
    int ao[4], bo[C::NBI];
    offs(c, ao, bo);
    const int nk = c.nk;
    if (!primed) {
        RAW_BARRIER();
        s = 0;
#pragma unroll
        for (int i = 0; i < NP; ++i) piece(c, ao, bo, 0, 0, i);
        if (MI == 2 && nk > 1) {
#pragma unroll
            for (int i = 0; i < NP; ++i) piece(c, ao, bo, 1, 1, i);
        }
    }
#pragma unroll 1
    for (int kt = 0; kt < nk; ++kt) {
        int ns, nkt;
        if (MI == 2) {
            if (kt + 1 < nk && kt > 0) asm volatile("s_waitcnt vmcnt(6)" ::: "memory"); else asm volatile("s_waitcnt vmcnt(0)" ::: "memory");
            RAW_BARRIER();
            ns = s >= 1 ? s - 1 : 2; nkt = kt + 2;
        } else {
            asm volatile("s_waitcnt vmcnt(0)" ::: "memory");
            RAW_BARRIER();
            ns = s ^ 1; nkt = kt + 1;
        }
        const bool doload = nkt < nk;
        const char* sb = smem + s * C::STAGE;
#pragma unroll
        for (int ks = 0; ks < 4; ++ks) {
            const int co = (lk ^ (2 * ks)) << 4;
            bf16x8 fa[MI], fb[2];
#pragma unroll
            for (int mi = 0; mi < MI; ++mi) fa[mi] = *(const bf16x8*)(sb + a_off + mi * 4096 + co);
            fb[0] = *(const bf16x8*)(sb + b_off + co); fb[1] = *(const bf16x8*)(sb + b_off + 4096 + co);
            asm volatile("" ::: "memory");
            if (doload) {
                constexpr int P0[5] = {0, (NP + 3) / 4, (NP + 3) / 4 + (NP + 2) / 4, (NP + 3) / 4 + (NP + 2) / 4 + (NP + 1) / 4, NP};
#pragma unroll
                for (int i = P0[ks]; i < P0[ks + 1]; ++i) piece(c, ao, bo, nkt, ns, i);
            }
            asm volatile("" ::: "memory");
#pragma unroll
            for (int mi = 0; mi < MI; ++mi)
#pragma unroll
                for (int ni = 0; ni < 2; ++ni) {
                    if (!SWAP) acc[mi][ni] = MFMA32(fa[mi], fb[ni], acc[mi][ni]);
                    else acc[mi][ni] = MFMA32(fb[ni], fa[mi], acc[mi][ni]);
                }
        }
        s = (s + 1 == NST) ? 0 : s + 1;
    }
    if (hasn) {
        offs(n, ao, bo);
#pragma unroll
        for (int i = 0; i < NP; ++i) piece(n, ao, bo, 0, s, i);
        if (MI == 2 && n.nk > 1) {
            const int s1 = (s + 1 == NST) ? 0 : s + 1;
#pragma unroll
            for (int i = 0; i < NP; ++i) piece(n, ao, bo, 1, s1, i);
        }
    }
}

template <int AMODE, bool SWAPO = true>
DI void mainloop_dma16(f32x4 (&acc)[4][2][2][2], const TD& c, const TD& n, bool hasn, bool primed, int& s, int tid) {
    constexpr int MI = 4; typedef Cfg<MI> C;
    const int l = tid & 63, w = tid >> 6, wr = w / C::NWC, wc = w % C::NWC, r16 = l & 15, q = l >> 4;
    const int key = (l >> 1) & 7;
    const int a_off = (wr * C::WROWS + r16) * 128, b_off = G_BOFF + (wc * 64 + r16) * 128;
#pragma unroll
    for (int mi = 0; mi < MI; ++mi)
#pragma unroll
        for (int ni = 0; ni < 2; ++ni)
#pragma unroll
            for (int rh = 0; rh < 2; ++rh)
#pragma unroll
                for (int ch = 0; ch < 2; ++ch) acc[mi][ni][rh][ch] = (f32x4){0.f, 0.f, 0.f, 0.f};
    constexpr int NP = 4 + C::NBI;
    auto offs = [&](const TD& t, int (&ao)[4], int (&bo)[C::NBI]) {
#pragma unroll
        for (int i = 0; i < 4; ++i) {
            int row = t.arow0 + (4 * w + i) * 8 + (l >> 3); row = row < 0 ? 0 : (row > t.amax ? t.amax : row);
            ao[i] = row * t.lda + ((l & 7) ^ (((l >> 4) + 4 * (i & 1)) & 7)) * 8;
        }
#pragma unroll
        for (int i = 0; i < C::NBI; ++i) {
            const int row = t.brow0 + (C::NBI * w + i) * 8 + (l >> 3);
            bo[i] = row * t.ldb + ((l & 7) ^ (((l >> 4) + 4 * (i & 1)) & 7)) * 8;
        }
    };
    auto piece = [&](const TD& t, const int (&ao)[4], const int (&bo)[C::NBI], int kt, int st, int i) {
        char* sb = smem + st * C::STAGE;
        if (i < 4) {
            const int ka = (AMODE == 1) ? ((kt >> 1) * 192 + (kt & 1) * 64) : kt * 64;
            __builtin_amdgcn_global_load_lds((const __attribute__((address_space(1))) void*)(t.A + ka + ao[i]), (__attribute__((address_space(3))) void*)(sb + (4 * w + i) * 1024), 16, 0, 0);
        } else {
            __builtin_amdgcn_global_load_lds((const __attribute__((address_space(1))) void*)(t.B + kt * 64 + bo[i - 4]), (__attribute__((address_space(3))) void*)(sb + G_BOFF + (C::NBI * w + i - 4) * 1024), 16, 0, 0);
        }
    };
    int ao[4], bo[C::NBI];
    offs(c, ao, bo);
    const int nk = c.nk;
    if (!primed) {
        RAW_BARRIER();
        s = 0;
#pragma unroll
        for (int i = 0; i < NP; ++i) piece(c, ao, bo, 0, 0, i);
    }
#pragma unroll 1
    for (int kt = 0; kt < nk; ++kt) {
        asm volatile("s_waitcnt vmcnt(0)" ::: "memory");
        RAW_BARRIER();
        const int ns = s ^ 1, nkt = kt + 1;
        const bool doload = nkt < nk;
        const char* sb = smem + s * C::STAGE;
#pragma unroll
        for (int k2 = 0; k2 < 2; ++k2) {
            const int co = ((4 * k2 + q) ^ key) << 4;
            bf16x8 fw[2][2];
#pragma unroll
            for (int ni = 0; ni < 2; ++ni)
#pragma unroll
                for (int rh = 0; rh < 2; ++rh) fw[ni][rh] = *(const bf16x8*)(sb + b_off + (ni * 32 + rh * 16) * 128 + co);
#pragma unroll
            for (int mh = 0; mh < 2; ++mh) {
                bf16x8 fx[2][2];
#pragma unroll
                for (int m2 = 0; m2 < 2; ++m2)
#pragma unroll
                    for (int ch = 0; ch < 2; ++ch) fx[m2][ch] = *(const bf16x8*)(sb + a_off + ((2 * mh + m2) * 32 + ch * 16) * 128 + co);
                asm volatile("" ::: "memory");
                if (doload) { const int p0 = (2 * k2 + mh) * 2; piece(c, ao, bo, nkt, ns, p0); piece(c, ao, bo, nkt, ns, p0 + 1); }
                asm volatile("" ::: "memory");
#pragma unroll
                for (int m2 = 0; m2 < 2; ++m2)
#pragma unroll
                    for (int ni = 0; ni < 2; ++ni)
#pragma unroll
                        for (int rh = 0; rh < 2; ++rh)
#pragma unroll
                            for (int ch = 0; ch < 2; ++ch)
                                acc[2 * mh + m2][ni][rh][ch] = SWAPO ? MFMA16(fw[ni][rh], fx[m2][ch], acc[2 * mh + m2][ni][rh][ch]) : MFMA16(fx[m2][ch], fw[ni][rh], acc[2 * mh + m2][ni][rh][ch]);
            }
        }
        s ^= 1;
    }
    if (hasn) {
        offs(n, ao, bo);
#pragma unroll
        for (int i = 0; i < NP; ++i) piece(n, ao, bo, 0, s, i);
    }
}

template <bool AF32, int AMODE, bool SWAP>
DI void mainloop(f32x16 (&acc)[2][2], const void* Abase, int lda, int arow0, int amax, const bf16_t* Bbase, int ldb, int brow0, int nk, int tid) {
    if constexpr (AF32) mainloop_rs<AF32, AMODE, SWAP>(acc, Abase, lda, arow0, amax, Bbase, ldb, brow0, nk, tid);
    else { int st = 0; const TD c = mk_td((const bf16_t*)Abase, lda, arow0, amax, Bbase, ldb, brow0, nk); mainloop_dma<AMODE, SWAP, 2>(acc, c, c, false, false, st, tid); }
}

DI void convT(const float* __restrict__ src, int K, int N, bf16_t* __restrict__ dst, int Npad, int mode, const float* __restrict__ gain, int vb, int nb, int& base, int tid) {
    float* tile = (float*)smem;
    const int nkt = K >> 6, ntiles = nkt * (Npad >> 6);
    int t0 = (vb - (base % nb) + nb) % nb;
    for (int t = t0; t < ntiles; t += nb) {
        const int kt = t % nkt, ntile = t / nkt, k0 = kt * 64, n0 = ntile * 64;
#pragma unroll
        for (int i = 0; i < 8; ++i) {
            const int k = (tid >> 6) + 8 * i, n = tid & 63, gn = n0 + n;
            float v = 0.f;
            if (gn < N) { v = src[(long)(k0 + k) * N + gn]; if (gain) v *= gain[k0 + k]; }
            tile[k * 65 + n] = v;
        }
        __syncthreads();
#pragma unroll
        for (int i = 0; i < 8; ++i) {
            const int n = (tid >> 6) + 8 * i, k = tid & 63, gn = n0 + n;
            int row = gn;
            if (mode == 1) { const int sub = gn >= DFF ? 1 : 0, c = gn - sub * DFF; row = (c >> 5) * 64 + sub * 32 + (c & 31); }
            dst[(long)row * K + k0 + k] = f2bf(tile[k * 65 + n]);
        }
        __syncthreads();
    }
    base += ntiles;
}

DI float wave_sum(float v) {
#pragma unroll
    for (int o = 32; o >= 1; o >>= 1) v += __shfl_xor(v, o);
    return v;
}

DI void prologue(const Params& P, int vb, int nb, int tid, int dry = 0) {
    (void)dry;
    bf16_t* WB = (bf16_t*)(P.ws + OFF_WB);
    int base = 0;
    for (int j = 0; j < 2; ++j) {
        bf16_t* wm = WB + WB_MLA + j * W_MLA_SZ;
        convT(P.mla_w_in + (size_t)j * 1024 * 832, 1024, 832, wm + W_MLA_IN, 896, 0, nullptr, vb, nb, base, tid);
        convT(P.mla_w_uq + (size_t)j * 512 * 3072, 512, 3072, wm + W_MLA_UQ, 3072, 0, P.mla_q_norm + j * 512, vb, nb, base, tid);
        convT(P.mla_w_uk + (size_t)j * 256 * 2048, 256, 2048, wm + W_MLA_KV, 2048, 0, P.mla_kv_norm + j * 256, vb, nb, base, tid);
        convT(P.mla_w_uv + (size_t)j * 256 * 2048, 256, 2048, wm + W_MLA_KV + 2048 * 256, 2048, 0, P.mla_kv_norm + j * 256, vb, nb, base, tid);
        convT(P.mla_w_o + (size_t)j * 2048 * 1024, 2048, 1024, wm + W_MLA_O, 1024, 0, nullptr, vb, nb, base, tid);
        bf16_t* wg = WB + WB_GLA + j * W_GLA_SZ;
        convT(P.gla_w_in + (size_t)j * 1024 * 3088, 1024, 3088, wg + W_GLA_IN, 3328, 0, nullptr, vb, nb, base, tid);
        convT(P.gla_w_o + (size_t)j * 1024 * 1024, 1024, 1024, wg + W_GLA_O, 1024, 0, nullptr, vb, nb, base, tid);
    }
    for (int i = 0; i < 4; ++i) {
        bf16_t* wf = WB + WB_FFN + i * W_FFN_SZ;
        convT(P.ffn_w_up + (size_t)i * 1024 * 5632, 1024, 5632, wf + W_FFN_UP, 5632, 1, nullptr, vb, nb, base, tid);
        convT(P.ffn_w_down + (size_t)i * 2816 * 1024, 2816, 1024, wf + W_FFN_DN, 1024, 0, nullptr, vb, nb, base, tid);
        bf16_t* wp = WB + WB_PLE + i * W_PLE_SZ;
        convT(P.ple_w_gate + (size_t)i * 1024 * 1024, 1024, 1024, wp + W_PLE_G, 1024, 0, nullptr, vb, nb, base, tid);
        convT(P.ple_w_proj + (size_t)i * 256 * 1024, 256, 1024, wp + W_PLE_P, 1024, 0, nullptr, vb, nb, base, tid);
    }
    {
        const f32x4* xs = (const f32x4*)P.x; f32x4* xo = (f32x4*)P.out; u32x2* xb = (u32x2*)(P.ws + OFF_XB);
        const int n4 = TT * DM / 4;
        for (int i = vb * NTH + tid; i < n4; i += nb * NTH) { f32x4 v = xs[i]; xb[i] = pk4(v.x, v.y, v.z, v.w); }
        (void)xo;
    }
    {
        float* COS = (float*)(P.ws + OFF_COS); float* SIN = (float*)(P.ws + OFF_SIN);
        for (int i = vb * NTH + tid; i < TT * 32; i += nb * NTH) {
            const int t = i >> 5, f = i & 31;
            double rev = (double)P.pos[t] * P.invrev[f];
            rev -= rint(rev);
            const float fr = (float)rev;
            COS[i] = __builtin_amdgcn_cosf(fr); SIN[i] = __builtin_amdgcn_sinf(fr);
        }
    }
    {
        int* CID = (int*)(P.ws + OFF_CID); int* TMIN = (int*)(P.ws + OFF_TMIN); int* TMAX = (int*)(P.ws + OFF_TMAX);
        const int l = tid & 63, w = tid >> 6;
        for (int tl = vb * 8 + w; tl < TT / 64; tl += nb * 8) {
            const int c = P.pos[tl * 64 + l] >> 6;
            CID[tl * 64 + l] = c;
            int mn = c, mx = c;
#pragma unroll
            for (int o = 32; o >= 1; o >>= 1) { mn = min(mn, __shfl_xor(mn, o)); mx = max(mx, __shfl_xor(mx, o)); }
            if (l == 0) { TMIN[tl] = mn; TMAX[tl] = mx; }
        }
    }
}

DI void ln_phase(const float* X32, bf16_t* Xb, f32x2* STATS, const float* __restrict__ g, const float* __restrict__ b, int vb, int nb, int tid, int dry = 0) {
    const int l = tid & 63, w = tid >> 6;
    f32x4 gg[4], bb[4];
#pragma unroll
    for (int j = 0; j < 4; ++j) { gg[j] = ((const f32x4*)g)[l + 64 * j]; bb[j] = ((const f32x4*)b)[l + 64 * j]; }
    constexpr int R = 4;
    const int stride = nb * 8;
    for (int row0 = vb * 8 + w; row0 < TT; row0 += R * stride) {
        f32x4 v[R][4]; float s[R];
#pragma unroll
        for (int r = 0; r < R; ++r) {
            const int row = row0 + r * stride; const f32x4* xr = (const f32x4*)(X32 + (size_t)(row < TT ? row : row0) * DM);
#pragma unroll
            for (int j = 0; j < 4; ++j) v[r][j] = xr[l + 64 * j];
        }
#pragma unroll
        for (int r = 0; r < R; ++r) { s[r] = 0.f;
#pragma unroll
            for (int j = 0; j < 4; ++j) s[r] += (v[r][j].x + v[r][j].y) + (v[r][j].z + v[r][j].w); }
#pragma unroll
        for (int o = 32; o >= 1; o >>= 1)
#pragma unroll
            for (int r = 0; r < R; ++r) s[r] += __shfl_xor(s[r], o);
        float mean[R], s2[R];
#pragma unroll
        for (int r = 0; r < R; ++r) { mean[r] = s[r] * (1.f / DM); s2[r] = 0.f;
#pragma unroll
            for (int j = 0; j < 4; ++j) { v[r][j] = v[r][j] - mean[r]; s2[r] += (v[r][j].x * v[r][j].x + v[r][j].y * v[r][j].y) + (v[r][j].z * v[r][j].z + v[r][j].w * v[r][j].w); } }
#pragma unroll
        for (int o = 32; o >= 1; o >>= 1)
#pragma unroll
            for (int r = 0; r < R; ++r) s2[r] += __shfl_xor(s2[r], o);
        if (!dry) {
#pragma unroll
            for (int r = 0; r < R; ++r) {
                const int row = row0 + r * stride;
                if (row < TT) {
                    const float rstd = __builtin_amdgcn_rsqf(s2[r] * (1.f / DM) + EPS);
                    u32x2* xb = (u32x2*)(Xb + (size_t)row * DM);
                    if (l == 0) STATS[row] = (f32x2){mean[r], rstd};
#pragma unroll
                    for (int j = 0; j < 4; ++j) { f32x4 o = v[r][j] * rstd * gg[j] + bb[j]; xb[l + 64 * j] = pk4(o.x, o.y, o.z, o.w); }
                }
            }
        }
    }
}

#define LAUNDER_TID int tid_e = tid; asm volatile("" : "+v"(tid_e));
#define LANE_DECODE_E(MI_) const int l = tid_e & 63, w = tid_e >> 6, wr = w / Cfg<MI_>::NWC, wc = w % Cfg<MI_>::NWC, h = l >> 5, li = l & 31; (void)l; (void)w; (void)wr; (void)wc; (void)h; (void)li;
#define LANE_DECODE_T(MI_) const int l = tid & 63, w = tid >> 6, wr = w / Cfg<MI_>::NWC, wc = w % Cfg<MI_>::NWC, h = l >> 5, li = l & 31; (void)l; (void)w; (void)wr; (void)wc; (void)h; (void)li;
#define LANE_DECODE const int l = tid & 63, w = tid >> 6, wr = w >> 1, wc = w & 1, h = l >> 5, li = l & 31; (void)l; (void)w; (void)wr; (void)wc; (void)h; (void)li;

template <class F>
DI void wave_rows_store(char* buf, int l, bf16_t* grow0, size_t ld, F vals) {
    const int li = l & 31, h = l >> 5;
#pragma unroll
    for (int ni = 0; ni < 2; ++ni)
#pragma unroll
        for (int g = 0; g < 4; ++g) *(u32x2*)(buf + li * 144 + ni * 64 + g * 16 + h * 8) = vals(ni, g);
#pragma unroll
    for (int jj = 0; jj < 4; ++jj) {
        const int row = (l >> 3) + 8 * jj;
        const u32x4 v = *(const u32x4*)(buf + row * 144 + (l & 7) * 16);
        *(u32x4*)(grow0 + (size_t)row * ld + (l & 7) * 8) = v;
    }
}

template <class F>
DI void wave_rows_store16(char* buf, int l, bf16_t* grow0, size_t ld, F vals) {
    const int r16 = l & 15, q = l >> 4;
#pragma unroll
    for (int ni = 0; ni < 2; ++ni)
#pragma unroll
        for (int rh = 0; rh < 2; ++rh) *(u32x2*)(buf + r16 * 144 + (ni * 32 + rh * 16 + 4 * q) * 2) = vals(ni, rh);
#pragma unroll
    for (int jj = 0; jj < 2; ++jj) {
        const int row = (l >> 3) + 8 * jj;
        const u32x4 v = *(const u32x4*)(buf + row * 144 + (l & 7) * 16);
        *(u32x4*)(grow0 + (size_t)row * ld + (l & 7) * 8) = v;
    }
}

DI void ph_mla_in(const Params& P, int j, int vb, int nb, int tid, int dry = 0) {
    (void)dry;
    LANE_DECODE
    const bf16_t* Xb = (const bf16_t*)(P.ws + (j == 0 ? OFF_XB : OFF_XBN_B)); const bf16_t* W = (const bf16_t*)(P.ws + OFF_WB) + WB_MLA + j * W_MLA_SZ + W_MLA_IN;
    bf16_t* H = (bf16_t*)(P.ws + OFF_H); float* SSQ = (float*)(P.ws + OFF_SSQ); bf16_t* KR = (bf16_t*)(P.ws + OFF_KROPE);
    const float* COS = (const float*)(P.ws + OFF_COS); const float* SIN = (const float*)(P.ws + OFF_SIN);
    constexpr int NT = 7, MT = TT / 256;
    auto td = [&](int tile) { return mk_td(Xb, DM, (tile / NT) * 256, TT - 1, W, 1024, (tile % NT) * 128, 16); };
    constexpr int NTILES_ = MT * NT; int stg = 0; bool primed = false;
    for (int tile = vb; tile < MT * NT; tile += nb) {
        const int mt = tile / NT, nt = tile % NT;
        f32x16 acc[2][2];
        { const TD c_ = td(tile); const bool hn_ = tile + nb < NTILES_; const TD n_ = td(hn_ ? tile + nb : tile); mainloop_dma<0, true, 2>(acc, c_, n_, hn_, primed, stg, tid); primed = hn_; }
        const int wt = nt * 2 + wc;
        if (wt < 12) {
#pragma unroll
            for (int mi = 0; mi < 2; ++mi) {
                const int tok = mt * 256 + wr * 64 + mi * 32 + li; float ss = 0.f;
#pragma unroll
                for (int ni = 0; ni < 2; ++ni)
#pragma unroll
                    for (int g = 0; g < 4; ++g) {
                        const float a = acc[mi][ni][4 * g], b = acc[mi][ni][4 * g + 1], c = acc[mi][ni][4 * g + 2], d = acc[mi][ni][4 * g + 3];
                        ss += (a * a + b * b) + (c * c + d * d);
                        *(u32x2*)(H + (size_t)tok * 768 + wt * 64 + ni * 32 + 8 * g + 4 * h) = pk4(a, b, c, d);
                    }
                ss += __shfl_xor(ss, 32);
                if (h == 0) SSQ[tok * 12 + wt] = ss;
            }
        } else if (wt == 12) {
#pragma unroll
            for (int mi = 0; mi < 2; ++mi) {
                const int tok = mt * 256 + wr * 64 + mi * 32 + li;
#pragma unroll
                for (int g = 0; g < 4; ++g) {
                    const int i0 = 8 * g + 4 * h;
                    const f32x4 c4 = *(const f32x4*)(COS + tok * 32 + i0), s4 = *(const f32x4*)(SIN + tok * 32 + i0);
                    float o1[4], o2[4];
#pragma unroll
                    for (int c = 0; c < 4; ++c) { const float x1 = acc[mi][0][4 * g + c], x2 = acc[mi][1][4 * g + c]; o1[c] = x1 * c4[c] - x2 * s4[c]; o2[c] = x1 * s4[c] + x2 * c4[c]; }
                    *(u32x2*)(KR + (size_t)tok * 64 + i0) = pk4(o1[0], o1[1], o1[2], o1[3]);
                    *(u32x2*)(KR + (size_t)tok * 64 + 32 + i0) = pk4(o2[0], o2[1], o2[2], o2[3]);
                }
            }
        }
    }
}

DI void ph_mla_up(const Params& P, int j, int half, int vb, int nb, int tid, int dry = 0) {
    (void)dry;
    constexpr int MI = 4; typedef Cfg<MI> C;
    const bf16_t* H = (const bf16_t*)(P.ws + OFF_H); const float* SSQ = (const float*)(P.ws + OFF_SSQ);
    const bf16_t* WQ = (const bf16_t*)(P.ws + OFF_WB) + WB_MLA + j * W_MLA_SZ + W_MLA_UQ; const bf16_t* WKV = (const bf16_t*)(P.ws + OFF_WB) + WB_MLA + j * W_MLA_SZ + W_MLA_KV;
    bf16_t* Q = (bf16_t*)(P.ws + OFF_Q); bf16_t* KN = (bf16_t*)(P.ws + OFF_KN); bf16_t* VT = (bf16_t*)(P.ws + OFF_VT);
    const float* COS = (const float*)(P.ws + OFF_COS); const float* SIN = (const float*)(P.ws + OFF_SIN);
    constexpr int MT = HALF_T / 256, NTQ = 3072 / C::BN, NTKV = 4096 / C::BN, TQ = MT * NTQ, TKV = MT * NTKV;
    const float QSCALE = 0.07216878364870322f * 1.4426950408889634f;
    auto td = [&](int tile) {
        if (tile < TQ) return mk_td(H, 768, half * HALF_T + (tile / NTQ) * 256, TT - 1, WQ, 512, (tile % NTQ) * C::BN, 8);
        const int t2 = tile - TQ; return mk_td(H + 512, 768, half * HALF_T + (t2 / NTKV) * 256, TT - 1, WKV, 256, (t2 % NTKV) * C::BN, 4);
    };
    constexpr int NTILES_ = TQ + TKV; int stg = 0; bool primed = false;
    for (int tile = vb; tile < TQ + TKV; tile += nb) {
        f32x16 acc[MI][2];
        { const TD c_ = td(tile); const bool hn_ = tile + nb < NTILES_; const TD n_ = td(hn_ ? tile + nb : tile); mainloop_dma<0, true, MI>(acc, c_, n_, hn_, primed, stg, tid); primed = hn_; }
        LAUNDER_TID LANE_DECODE_E(MI)
        __syncthreads();
        char* ebuf = smem + (stg ^ 1) * C::STAGE + w * 4608;
        if (tile < TQ) {
            const int mt = tile / NTQ, nt = tile % NTQ, tok0 = half * HALF_T + mt * 256;
            const int wt = nt * C::NWC + wc, head = wt / 3, part = wt - head * 3;
#pragma unroll
            for (int mi = 0; mi < MI; ++mi) {
                const int tok = tok0 + wr * C::WROWS + mi * 32 + li, tl = tok - half * HALF_T;
                const f32x4 s0 = *(const f32x4*)(SSQ + tok * 12), s1 = *(const f32x4*)(SSQ + tok * 12 + 4);
                const float rs = __builtin_amdgcn_rsqf(((s0.x + s0.y) + (s0.z + s0.w) + (s1.x + s1.y) + (s1.z + s1.w)) * (1.f / 512.f) + EPS) * QSCALE;
                bf16_t* dst = Q + (size_t)tl * 3072 + head * 192 + part * 64;
                bf16_t* drow0 = Q + (size_t)(tok0 - half * HALF_T + wr * C::WROWS + mi * 32) * 3072 + head * 192 + part * 64;
                if (part < 2) {
                    wave_rows_store(ebuf, l, drow0, 3072, [&](int ni, int g) { return pk4(acc[mi][ni][4 * g] * rs, acc[mi][ni][4 * g + 1] * rs, acc[mi][ni][4 * g + 2] * rs, acc[mi][ni][4 * g + 3] * rs); });
                } else {
#pragma unroll
                    for (int g = 0; g < 4; ++g) {
                        const int i0 = 8 * g + 4 * h;
                        const f32x4 c4 = *(const f32x4*)(COS + tok * 32 + i0), s4 = *(const f32x4*)(SIN + tok * 32 + i0);
                        float o1[4], o2[4];
#pragma unroll
                        for (int c = 0; c < 4; ++c) { const float x1 = acc[mi][0][4 * g + c] * rs, x2 = acc[mi][1][4 * g + c] * rs; o1[c] = x1 * c4[c] - x2 * s4[c]; o2[c] = x1 * s4[c] + x2 * c4[c]; }
                        *(u32x2*)(dst + i0) = pk4(o1[0], o1[1], o1[2], o1[3]);
                        *(u32x2*)(dst + 32 + i0) = pk4(o2[0], o2[1], o2[2], o2[3]);
                    }
                }
            }
        } else {
            const int t2 = tile - TQ, mt = t2 / NTKV, nt = t2 % NTKV, tok0 = half * HALF_T + mt * 256;
            const int ncol0 = nt * C::BN + wc * 64;
#pragma unroll
            for (int mi = 0; mi < MI; ++mi) {
                const int tok = tok0 + wr * C::WROWS + mi * 32 + li, tl = tok - half * HALF_T;
                const f32x4 s0 = *(const f32x4*)(SSQ + tok * 12 + 8);
                const float rs = __builtin_amdgcn_rsqf(((s0.x + s0.y) + (s0.z + s0.w)) * (1.f / 256.f) + EPS);
                if (ncol0 < 2048) {
                    wave_rows_store(ebuf, l, KN + (size_t)(tok0 - half * HALF_T + wr * C::WROWS + mi * 32) * 2048 + ncol0, 2048,
                                    [&](int ni, int g) { return pk4(acc[mi][ni][4 * g] * rs, acc[mi][ni][4 * g + 1] * rs, acc[mi][ni][4 * g + 2] * rs, acc[mi][ni][4 * g + 3] * rs); });
                } else {
                    const int bl = tl >> 12, sq = tl & 4095;
#pragma unroll
                    for (int ni = 0; ni < 2; ++ni)
#pragma unroll
                        for (int r = 0; r < 16; ++r) {
                            const int n = ncol0 - 2048 + ni * 32 + 8 * (r >> 2) + 4 * h + (r & 3);
                            VT[((size_t)(bl * 2048 + n)) * 4096 + sq] = f2bf(acc[mi][ni][r] * rs);
                        }
                }
            }
        }
    }
}

template <int AMODE, bool PEND>
DI void ph_res(const Params& P, const bf16_t* A, int lda, int K, const bf16_t* W, int tokbase, int ntok, const float* lg, const float* lb, const float* Xsrc, int vb, int nb, int tid, int dry = 0) {
    constexpr int MI = 4; typedef Cfg<MI> C;
    float* X32 = P.out;
    const int MT = ntok / 256; constexpr int NT = 1024 / C::BN;
    auto td = [&](int tile) { return mk_td(A, lda, (tile / NT) * 256, ntok - 1, W, K, (tile % NT) * C::BN, K / 64); };
    const int NTILES_ = MT * NT; int stg = 0; bool primed = false;
    for (int tile = vb; tile < MT * NT; tile += nb) {
        const int mt = tile / NT, nt = tile % NT;
        f32x4 acc[MI][2][2][2];
        { const TD c_ = td(tile); const bool hn_ = tile + nb < NTILES_; const TD n_ = td(hn_ ? tile + nb : tile); mainloop_dma16<AMODE>(acc, c_, n_, hn_, primed, stg, tid); primed = hn_; }
        int tid_e = tid; asm volatile("" : "+v"(tid_e));
        const int l = tid_e & 63, w = tid_e >> 6, wr = w / C::NWC, wc = w % C::NWC, r16 = l & 15, q = l >> 4;
        const int colb = nt * C::BN + wc * 64 + 4 * q;
        f32x4 g4[2][2], b4[2][2];
        if (PEND) {
#pragma unroll
            for (int ni = 0; ni < 2; ++ni)
#pragma unroll
                for (int rh = 0; rh < 2; ++rh) { g4[ni][rh] = *(const f32x4*)(lg + colb + ni * 32 + rh * 16); b4[ni][rh] = *(const f32x4*)(lb + colb + ni * 32 + rh * 16); }
        }
        const int tokb = tokbase + mt * 256 + wr * C::WROWS + r16;
        f32x4 nx[2][2]; f32x2 nst = {0.f, 1.f};
        auto ldgrp = [&](int grp) {
            const int tok = tokb + (grp >> 1) * 32 + (grp & 1) * 16;
            if (PEND) nst = ((const f32x2*)(P.ws + OFF_STATS))[tok];
#pragma unroll
            for (int ni = 0; ni < 2; ++ni)
#pragma unroll
                for (int rh = 0; rh < 2; ++rh) nx[ni][rh] = *(const f32x4*)(Xsrc + (size_t)tok * DM + colb + ni * 32 + rh * 16);
        };
        ldgrp(0);
#pragma unroll
        for (int grp = 0; grp < 8; ++grp) {
            const int mi = grp >> 1, ch = grp & 1, tok = tokb + mi * 32 + ch * 16;
            f32x4 o[2][2]; const f32x2 st = nst;
#pragma unroll
            for (int ni = 0; ni < 2; ++ni)
#pragma unroll
                for (int rh = 0; rh < 2; ++rh) o[ni][rh] = nx[ni][rh];
            if (grp + 1 < 8) ldgrp(grp + 1);
#pragma unroll
            for (int ni = 0; ni < 2; ++ni)
#pragma unroll
                for (int rh = 0; rh < 2; ++rh) {
                    f32x4 v = o[ni][rh];
                    if (PEND) v = (v - st.x) * st.y * g4[ni][rh] + b4[ni][rh];
                    v = v * DN_ALPHA + acc[mi][ni][rh][ch];
                    if (!dry) *(f32x4*)(X32 + (size_t)tok * DM + colb + ni * 32 + rh * 16) = v;
                }
        }
    }
}

DI void ph_gla_in(const Params& P, int j, int vb, int nb, int tid, int dry = 0) {
    (void)dry;
    constexpr int MI = 4; typedef Cfg<MI> C;
    const bf16_t* Xb = (const bf16_t*)(P.ws + OFF_XBN_A); const bf16_t* W = (const bf16_t*)(P.ws + OFF_WB) + WB_GLA + j * W_GLA_SZ + W_GLA_IN;
    bf16_t* GQ = (bf16_t*)(P.ws + OFF_GQ); bf16_t* GK = (bf16_t*)(P.ws + OFF_GK); bf16_t* GVT = (bf16_t*)(P.ws + OFF_GVT); bf16_t* GR = (bf16_t*)(P.ws + OFF_GR); float* GA = (float*)(P.ws + OFF_GA);
    constexpr int NT = 13, MT = TT / 256;
    auto td = [&](int tile) { return mk_td(Xb, DM, (tile / NT) * 256, TT - 1, W, 1024, (tile % NT) * C::BN, 16); };
    constexpr int NTILES_ = MT * NT; int stg = 0; bool primed = false;
    for (int tile = vb; tile < MT * NT; tile += nb) {
        const int mt = tile / NT, nt = tile % NT;
        f32x4 acc[MI][2][2][2];
        const bool vtile = nt >= 4 && nt < 8;
        { const TD c_ = td(tile); const bool hn_ = tile + nb < NTILES_; const TD n_ = td(hn_ ? tile + nb : tile);
          if (vtile) mainloop_dma16<0, false>(acc, c_, n_, hn_, primed, stg, tid); else mainloop_dma16<0, true>(acc, c_, n_, hn_, primed, stg, tid);
          primed = hn_; }
        int tid_e = tid; asm volatile("" : "+v"(tid_e));
        const int l = tid_e & 63, w = tid_e >> 6, wr = w / C::NWC, wc = w % C::NWC, r16 = l & 15, q = l >> 4;
        __syncthreads();
        char* ebuf = smem + (stg ^ 1) * C::STAGE + w * 2304;
        if (vtile) {
#pragma unroll
            for (int mi = 0; mi < MI; ++mi)
#pragma unroll
                for (int ch = 0; ch < 2; ++ch) {
                    const int tok = mt * 256 + wr * C::WROWS + mi * 32 + ch * 16 + 4 * q, bb = tok >> 12, sq = tok & 4095;
#pragma unroll
                    for (int ni = 0; ni < 2; ++ni)
#pragma unroll
                        for (int rh = 0; rh < 2; ++rh) {
                            const int n = (nt * C::BN + wc * 64 - 1024) + ni * 32 + rh * 16 + r16;
                            const f32x4 v = acc[mi][ni][rh][ch];
                            *(u32x2*)(GVT + ((size_t)(bb * 1024 + n)) * 4096 + sq) = pk4(v.x, v.y, v.z, v.w);
                        }
                }
            continue;
        }
        const int wt = nt * C::NWC + wc;
#pragma unroll
        for (int mi = 0; mi < MI; ++mi)
#pragma unroll
            for (int ch = 0; ch < 2; ++ch) {
                const int tok = mt * 256 + wr * C::WROWS + mi * 32 + ch * 16 + r16;
                if (wt < 16) {
                    bf16_t* dst0 = (wt < 8 ? GQ + wt * 64 : GK + (wt - 8) * 64) + (size_t)(tok - r16) * 512;
                    const float sc = wt < 8 ? 0.08838834764831845f : 1.f;
                    wave_rows_store16(ebuf, l, dst0, 512, [&](int ni, int rh) { const f32x4 v = acc[mi][ni][rh][ch] * sc; return pk4(v.x, v.y, v.z, v.w); });
                } else if (wt < 32) {
                    const int bb = tok >> 12, sq = tok & 4095;
#pragma unroll
                    for (int ni = 0; ni < 2; ++ni)
#pragma unroll
                        for (int rh = 0; rh < 2; ++rh)
#pragma unroll
                            for (int r = 0; r < 4; ++r) {
                                const int n = (wt - 16) * 64 + ni * 32 + rh * 16 + 4 * q + r;
                                GVT[((size_t)(bb * 1024 + n)) * 4096 + sq] = f2bf(acc[mi][ni][rh][ch][r]);
                            }
                } else if (wt < 48) {
                    bf16_t* dst0 = GR + (size_t)(tok - r16) * 1024 + (wt - 32) * 64;
                    wave_rows_store16(ebuf, l, dst0, 1024, [&](int ni, int rh) { const f32x4 x = acc[mi][ni][rh][ch]; return pk4(x.x * sigmoidf_(x.x), x.y * sigmoidf_(x.y), x.z * sigmoidf_(x.z), x.w * sigmoidf_(x.w)); });
                } else if (wt == 48) {
                    *(f32x4*)(GA + (size_t)tok * 16 + 4 * q) = acc[mi][0][0][ch];
                }
            }
    }
}

DI void ph_ffn_up(const Params& P, int L, int vb, int nb, int tid, int dry = 0) {
    (void)dry;
    constexpr int MI = 4; typedef Cfg<MI> C;
    const bf16_t* Xb = (const bf16_t*)(P.ws + OFF_XB); const bf16_t* W = (const bf16_t*)(P.ws + OFF_WB) + WB_FFN + L * W_FFN_SZ + W_FFN_UP;
    bf16_t* GT = (bf16_t*)(P.ws + OFF_GATED);
    const float* cw = P.ffn_conv_w + (size_t)L * 3 * 5632; const float* cb = P.ffn_conv_b + (size_t)L * 5632;
    float* xch = (float*)(smem + XCH_OFF);
    constexpr int NT = 5632 / C::BN, MT = (TT + 253) / 254;
    auto tmap = [&](int lin, int& mt, int& nt) { const int panel = lin / (MT * 4), within = lin - panel * (MT * 4), pw = (NT - panel * 4) < 4 ? (NT - panel * 4) : 4; mt = within / pw; nt = panel * 4 + within % pw; };
    auto td = [&](int lin) { int mt, nt; tmap(lin, mt, nt); return mk_td(Xb, DM, mt * 254 - 2, TT - 1, W, 1024, nt * C::BN, 16); };
    constexpr int NTILES_ = MT * NT; int stg = 0; bool primed = false;
    for (int tile = vb; tile < MT * NT; tile += nb) {
        int mt, nt; tmap(tile, mt, nt);
        f32x4 acc[MI][2][2][2];
        { const TD c_ = td(tile); const bool hn_ = tile + nb < NTILES_; const TD n_ = td(hn_ ? tile + nb : tile); mainloop_dma16<0, false>(acc, c_, n_, hn_, primed, stg, tid); primed = hn_; }
        int tid_e = tid; asm volatile("" : "+v"(tid_e));
        const int l = tid_e & 63, w = tid_e >> 6, wr = w / C::NWC, wc = w % C::NWC, r16 = l & 15, q = l >> 4;
        const int wv = wr * C::NWC + wc, rot = (l + 48) & 63;
        if (q == 3) {
#pragma unroll
            for (int ug = 0; ug < 2; ++ug)
#pragma unroll
                for (int rh = 0; rh < 2; ++rh) {
                    xch[((((wv * 2 + 0) * 2 + ug) * 2 + rh) << 4) + r16] = acc[MI - 1][ug][rh][1][2];
                    xch[((((wv * 2 + 1) * 2 + ug) * 2 + rh) << 4) + r16] = acc[MI - 1][ug][rh][1][3];
                }
        }
        float wka[2][2][3], bka[2][2];
#pragma unroll
        for (int rh = 0; rh < 2; ++rh)
#pragma unroll
            for (int ug = 0; ug < 2; ++ug) {
                const int col = ug * DFF + (nt * C::NWC + wc) * 32 + rh * 16 + r16;
                wka[rh][ug][0] = cw[col]; wka[rh][ug][1] = cw[5632 + col]; wka[rh][ug][2] = cw[2 * 5632 + col]; bka[rh][ug] = cb[col];
            }
        asm volatile("s_waitcnt vmcnt(0)" ::: "memory");
        __syncthreads();
        const int tlo = (mt * 254 - 2) < 0 ? 0 : (mt * 254 - 2), rlo = tlo & 4095;
        const bool has_start = (rlo <= 1) || (rlo + 256 > 4096);
        auto epi = [&](auto padc) {
        constexpr bool PAD = decltype(padc)::value;
#pragma unroll
        for (int rh = 0; rh < 2; ++rh) {
            const int cu = (nt * C::NWC + wc) * 32 + rh * 16 + r16;
            float wk[2][3], bk[2], c2[2], c3[2];
#pragma unroll
            for (int ug = 0; ug < 2; ++ug) {
                wk[ug][0] = wka[rh][ug][0]; wk[ug][1] = wka[rh][ug][1]; wk[ug][2] = wka[rh][ug][2]; bk[ug] = bka[rh][ug];
                c2[ug] = wr > 0 ? xch[(((((wv - C::NWC) * 2 + 0) * 2 + ug) * 2 + rh) << 4) + r16] : 0.f;
                c3[ug] = wr > 0 ? xch[(((((wv - C::NWC) * 2 + 1) * 2 + ug) * 2 + rh) << 4) + r16] : 0.f;
            }
#pragma unroll
            for (int mi = 0; mi < MI; ++mi)
#pragma unroll
                for (int ch = 0; ch < 2; ++ch) {
                    const int i0 = wr * C::WROWS + mi * 32 + ch * 16 + 4 * q;
                    const int t0 = mt * 254 - 2 + i0;
                    float y[2][4];
#pragma unroll
                    for (int ug = 0; ug < 2; ++ug) {
                        const f32x4 x = acc[mi][ug][rh][ch];
                        const float r2 = __shfl(x[2], rot), r3 = __shfl(x[3], rot);
                        const float pm2 = q ? r2 : c2[ug], pm1 = q ? r3 : c3[ug];
                        c2[ug] = r2; c3[ug] = r3;
                        const float vals[6] = {pm2, pm1, x[0], x[1], x[2], x[3]};
#pragma unroll
                        for (int c = 0; c < 4; ++c) {
                            const int sq = (t0 + c) & 4095;
                            const float t1 = (!PAD || sq >= 1) ? vals[c + 1] : 0.f, t2 = (!PAD || sq >= 2) ? vals[c] : 0.f;
                            y[ug][c] = __builtin_fmaf(wk[ug][0], t2, __builtin_fmaf(wk[ug][1], t1, __builtin_fmaf(wk[ug][2], vals[c + 2], bk[ug])));
                        }
                    }
                    const int goff = t0 * DFF + cu;
                    if (mt < MT - 1 && (mi | ch) != 0) {
#pragma unroll
                        for (int c = 0; c < 4; ++c) GT[goff + c * DFF] = f2bf(y[0][c] * gelu_tanh(y[1][c]));
                    } else {
#pragma unroll
                        for (int c = 0; c < 4; ++c) {
                            const int t = t0 + c;
                            if (i0 + c >= 2 && t < TT) GT[goff + c * DFF] = f2bf(y[0][c] * gelu_tanh(y[1][c]));
                        }
                    }
                }
        }
        };
        if (has_start) epi(std::true_type{}); else epi(std::false_type{});
    }
}

DI void ph_ple(const Params& P, int L, const float* lg, const float* lb, int vb, int nb, int tid, int dry = 0) {
    LANE_DECODE
    const bf16_t* Xbc = (const bf16_t*)(P.ws + OFF_XB); bf16_t* Xb = (bf16_t*)(P.ws + OFF_XB);
    const bf16_t* WG = (const bf16_t*)(P.ws + OFF_WB) + WB_PLE + L * W_PLE_SZ + W_PLE_G; const bf16_t* WP = (const bf16_t*)(P.ws + OFF_WB) + WB_PLE + L * W_PLE_SZ + W_PLE_P;
    const float* pp = P.p + (size_t)L * TT * 256; const float* bg = P.ple_b_gate + L * 1024;
    float* X32 = P.out;
    constexpr int NT = 8, MT = TT / 256;
    bf16_t* XB2 = (bf16_t*)(P.ws + ((L & 1) ? OFF_XBN_B : OFF_XBN_A));
    for (int tile = vb; tile < MT * NT; tile += nb) {
        const int mt = tile / NT, nt = tile % NT;
        f32x16 accg[2][2];
        unsigned pp2[2][2][8];
        {
            f32x16 accp[2][2];
            mainloop<true, 0, true>(accp, pp, 256, mt * 256, TT - 1, WP, 256, nt * 128, 4, tid);
#pragma unroll
            for (int mi = 0; mi < 2; ++mi)
#pragma unroll
                for (int ni = 0; ni < 2; ++ni)
#pragma unroll
                    for (int q = 0; q < 8; ++q) pp2[mi][ni][q] = pk2(accp[mi][ni][2 * q], accp[mi][ni][2 * q + 1]);
        }
        mainloop<false, 0, true>(accg, Xbc, DM, mt * 256, TT - 1, WG, 1024, nt * 128, 16, tid);
        const int tokA = mt * 256 + wr * 64 + li;
        f32x2 st2[2];
#pragma unroll
        for (int mi = 0; mi < 2; ++mi) st2[mi] = ((const f32x2*)(P.ws + OFF_STATS))[tokA + mi * 32];
        const int colq = nt * 128 + wc * 64 + 4 * h;
        f32x4 nb4, ng4, nl4, nx[2];
        auto ldq = [&](int k) {
            const int col = colq + (k >> 2) * 32 + (k & 3) * 8;
            nb4 = *(const f32x4*)(bg + col); ng4 = *(const f32x4*)(lg + col); nl4 = *(const f32x4*)(lb + col);
#pragma unroll
            for (int mi = 0; mi < 2; ++mi) nx[mi] = *(const f32x4*)(X32 + (size_t)(tokA + mi * 32) * DM + col);
        };
        ldq(0);
#pragma unroll
        for (int k = 0; k < 8; ++k) {
            const int ni = k >> 2, g = k & 3, col = colq + ni * 32 + g * 8;
            const f32x4 b4 = nb4, g4 = ng4, bl4 = nl4; f32x4 xo[2];
#pragma unroll
            for (int mi = 0; mi < 2; ++mi) xo[mi] = nx[mi];
            if (k + 1 < 8) ldq(k + 1);
#pragma unroll
            for (int mi = 0; mi < 2; ++mi) {
                const unsigned p01 = pp2[mi][ni][2 * g], p23 = pp2[mi][ni][2 * g + 1];
                f32x4 o = (xo[mi] - st2[mi].x) * st2[mi].y * g4 + bl4;
                o.x += sigmoidf_(accg[mi][ni][4 * g] + b4.x) * bf2f(p01 & 0xffffu);
                o.y += sigmoidf_(accg[mi][ni][4 * g + 1] + b4.y) * bf2f(p01 >> 16);
                o.z += sigmoidf_(accg[mi][ni][4 * g + 2] + b4.z) * bf2f(p23 & 0xffffu);
                o.w += sigmoidf_(accg[mi][ni][4 * g + 3] + b4.w) * bf2f(p23 >> 16);
                if (!dry) { *(f32x4*)(X32 + (size_t)(tokA + mi * 32) * DM + col) = o; *(u32x2*)(XB2 + (size_t)(tokA + mi * 32) * DM + col) = pk4(o.x, o.y, o.z, o.w); }
            }
        }
    }
    (void)Xb;
}

DI void ph_copy_xb(const Params& P, int vb, int nb, int tid, int dry = 0) {
    (void)dry;
    const u32x4* s = (const u32x4*)(P.ws + OFF_GATED); u32x4* d = (u32x4*)(P.ws + OFF_XB);
    const int n = TT * DM / 8;
    for (int i = vb * NTH + tid; i < n; i += nb * NTH) d[i] = s[i];
}

DI void ph_attn(const Params& P, int half, int vb, int nb, int tid, int dry = 0) {
    const int l = tid & 63, w = tid >> 6, r16 = l & 15, qq = l >> 4;
    bf16_t* Q = (bf16_t*)(P.ws + OFF_Q); const bf16_t* KN = (const bf16_t*)(P.ws + OFF_KN); const bf16_t* VT = (const bf16_t*)(P.ws + OFF_VT); const bf16_t* KR = (const bf16_t*)(P.ws + OFF_KROPE);
    const int* CID = (const int*)(P.ws + OFF_CID); const int* TMIN = (const int*)(P.ws + OFF_TMIN); const int* TMAX = (const int*)(P.ws + OFF_TMAX);
    const int krow0 = 8 * (r16 >> 2) + (r16 & 3);
    const int kkey = 2 * ((r16 >> 1) & 1) + 4 * ((r16 >> 3) & 1);
    const int vkey = (r16 >> 1) & 7;
    for (int u = vb; u < 1024; u += nb) {
        const int r = u >> 8, v = u & 255, xcd = v >> 5, slot = v & 31, gq = slot & 3, rw = (r + ((slot >> 2) & 3)) & 3;
        const int bh = xcd * 8 + 2 * r + (slot >> 4), bl = bh >> 4, head = bh & 15;
        const int qt = (rw == 0) ? 15 - gq : (rw == 1) ? 8 + gq : (rw == 2) ? 7 - gq : gq;
        const int q0 = qt * 256, nkt = 4 * qt + 4;
        const int tlb = bl * 4096, gtb = half * HALF_T + tlb;
        const int qs0 = q0 + w * 32 + r16;
        bf16x8 qf[6][2];
#pragma unroll
        for (int ds = 0; ds < 6; ++ds)
#pragma unroll
            for (int qb = 0; qb < 2; ++qb) qf[ds][qb] = *(const bf16x8*)(Q + (size_t)(tlb + qs0 + 16 * qb) * 3072 + head * 192 + ds * 32 + qq * 8);
        int tminq = TMIN[(gtb + q0) >> 6];
#pragma unroll
        for (int i = 1; i < 4; ++i) tminq = min(tminq, TMIN[((gtb + q0) >> 6) + i]);
        float m[2] = {-1e30f, -1e30f}, lsum[2] = {0.f, 0.f};
        f32x4 ao[8][2];
#pragma unroll
        for (int d = 0; d < 8; ++d)
#pragma unroll
            for (int qb = 0; qb < 2; ++qb) ao[d][qb] = (f32x4){0.f, 0.f, 0.f, 0.f};
        unsigned koff[3], kst[3], voff[2];
#pragma unroll
        for (int i = 0; i < 3; ++i) {
            const int bb = 1024 * (3 * w + i) + 16 * l, rw = bb / 384, pc = (bb - 384 * rw) >> 4, c = (pc & 24) | ((pc ^ (2 * ((rw >> 1) & 1) + 4 * ((rw >> 4) & 1))) & 7);
            if (c < 16) { koff[i] = (unsigned)(OFF_KN + ((size_t)(tlb + rw) * 2048 + head * 128 + c * 8) * 2); kst[i] = 64 * 2048 * 2; }
            else { koff[i] = (unsigned)(OFF_KROPE + ((size_t)(gtb + rw) * 64 + (c - 16) * 8) * 2); kst[i] = 64 * 64 * 2; }
        }
#pragma unroll
        for (int i = 0; i < 2; ++i) {
            const int row = 8 * (2 * w + i) + (l >> 3), c = (l & 7) ^ ((row >> 1) & 7);
            voff[i] = (unsigned)(OFF_VT + (((size_t)(bl * 2048 + head * 128 + row)) * 4096 + c * 8) * 2);
        }
        auto issue = [&](int kt, int st) {
            char* sb = smem + st * AT_STAGE;
#pragma unroll
            for (int i = 0; i < 3; ++i)
                __builtin_amdgcn_global_load_lds((const __attribute__((address_space(1))) void*)(P.ws + (koff[i] + (unsigned)kt * kst[i])), (__attribute__((address_space(3))) void*)(sb + (3 * w + i) * 1024), 16, 0, 0);
#pragma unroll
            for (int i = 0; i < 2; ++i)
                __builtin_amdgcn_global_load_lds((const __attribute__((address_space(1))) void*)(P.ws + (voff[i] + (unsigned)kt * 128u)), (__attribute__((address_space(3))) void*)(sb + AT_KB + (2 * w + i) * 1024), 16, 0, 0);
        };
        __syncthreads();
        issue(0, 0); asm volatile("s_waitcnt vmcnt(0)" ::: "memory"); __syncthreads();
        for (int kt = 0; kt < nkt; ++kt) {
            const bool more = kt + 1 < nkt;
            if (more) issue(kt + 1, (kt + 1) & 1);
            const char* sb = smem + (kt & 1) * AT_STAGE;
            f32x4 as[4][2];
#pragma unroll
            for (int kb = 0; kb < 4; ++kb)
#pragma unroll
                for (int qb = 0; qb < 2; ++qb) as[kb][qb] = (f32x4){0.f, 0.f, 0.f, 0.f};
#pragma unroll
            for (int ds = 0; ds < 6; ++ds) {
                const int ch = 4 * ds + qq;
#pragma unroll
                for (int kb = 0; kb < 4; ++kb) {
                    const int krow = krow0 + 32 * (kb >> 1) + 4 * (kb & 1), key = kkey;
                    const bf16x8 kf = *(const bf16x8*)(sb + krow * 384 + (((ch & 24) | ((ch ^ key) & 7)) << 4));
#pragma unroll
                    for (int qb = 0; qb < 2; ++qb) as[kb][qb] = MFMA16(kf, qf[ds][qb], as[kb][qb]);
                }
            }
            const bool need_mask = (kt >= 4 * qt) || (TMAX[((gtb) >> 6) + kt] > tminq);
            if (need_mask) {
#pragma unroll
                for (int qb = 0; qb < 2; ++qb) {
                    const int qsr = qs0 + 16 * qb, cidq = CID[gtb + qsr], q1lim = ((qsr >> 7) + 1) << 7;
#pragma unroll
                    for (int k2 = 0; k2 < 2; ++k2) {
                        const int kbase = kt * 64 + 32 * k2 + 8 * qq;
                        const i32x4 c0 = *(const i32x4*)(CID + gtb + kbase), c1 = *(const i32x4*)(CID + gtb + kbase + 4);
#pragma unroll
                        for (int rr = 0; rr < 4; ++rr) {
                            if (!((kbase + rr < q1lim) && (c0[rr] <= cidq))) as[2 * k2][qb][rr] = -1e30f;
                            if (!((kbase + 4 + rr < q1lim) && (c1[rr] <= cidq))) as[2 * k2 + 1][qb][rr] = -1e30f;
                        }
                    }
                }
            }
            float alpha[2];
#pragma unroll
            for (int qb = 0; qb < 2; ++qb) {
                float mx = as[0][qb][0];
#pragma unroll
                for (int kb = 0; kb < 4; ++kb)
#pragma unroll
                    for (int rr = 0; rr < 4; ++rr) mx = fmaxf(mx, as[kb][qb][rr]);
                mx = fmaxf(mx, __shfl_xor(mx, 16)); mx = fmaxf(mx, __shfl_xor(mx, 32));
                const float mnew = fmaxf(m[qb], mx);
                alpha[qb] = fexp2(m[qb] - mnew); m[qb] = mnew;
                float ps = 0.f;
#pragma unroll
                for (int kb = 0; kb < 4; ++kb)
#pragma unroll
                    for (int rr = 0; rr < 4; ++rr) { const float pv = fexp2(as[kb][qb][rr] - mnew); as[kb][qb][rr] = pv; ps += pv; }
                lsum[qb] = lsum[qb] * alpha[qb] + ps;
            }
            if (__builtin_amdgcn_ballot_w64(alpha[0] != 1.f || alpha[1] != 1.f) != 0ull) {
#pragma unroll
                for (int d = 0; d < 8; ++d)
#pragma unroll
                    for (int qb = 0; qb < 2; ++qb) ao[d][qb] = ao[d][qb] * alpha[qb];
            }
            bf16x8 pf[2][2];
#pragma unroll
            for (int k2 = 0; k2 < 2; ++k2)
#pragma unroll
                for (int qb = 0; qb < 2; ++qb) {
                    u32x4 pkd;
                    pkd.x = pk2(as[2 * k2][qb][0], as[2 * k2][qb][1]); pkd.y = pk2(as[2 * k2][qb][2], as[2 * k2][qb][3]);
                    pkd.z = pk2(as[2 * k2 + 1][qb][0], as[2 * k2 + 1][qb][1]); pkd.w = pk2(as[2 * k2 + 1][qb][2], as[2 * k2 + 1][qb][3]);
                    pf[k2][qb] = __builtin_bit_cast(bf16x8, pkd);
                }
#pragma unroll
            for (int k2 = 0; k2 < 2; ++k2) {
                const int ph = ((4 * k2 + qq) ^ vkey) << 4;
#pragma unroll
                for (int d = 0; d < 8; ++d) {
                    const bf16x8 vf = *(const bf16x8*)(sb + AT_KB + (d * 16 + r16) * 128 + ph);
#pragma unroll
                    for (int qb = 0; qb < 2; ++qb) ao[d][qb] = MFMA16(vf, pf[k2][qb], ao[d][qb]);
                }
            }
            asm volatile("s_waitcnt vmcnt(0)" ::: "memory");
            __syncthreads();
        }
        if (!dry) {
#pragma unroll
            for (int qb = 0; qb < 2; ++qb) {
                float ls = lsum[qb]; ls += __shfl_xor(ls, 16); ls += __shfl_xor(ls, 32);
                const float inv = frcp(ls);
                bf16_t* orow = Q + (size_t)(tlb + qs0 + 16 * qb) * 3072 + head * 192 + 4 * qq;
#pragma unroll
                for (int d = 0; d < 8; ++d) { const f32x4 o = ao[d][qb] * inv; *(u32x2*)(orow + d * 16) = pk4(o.x, o.y, o.z, o.w); }
            }
        }
    }
}

DI void ph_gla_scan(const Params& P, int j, int vb, int nb, int tid, int dry = 0) {
    (void)dry;
    const int l = tid & 63, w = tid >> 6;
    const float* GA = (const float*)(P.ws + OFF_GA); const bf16_t* GK = (const bf16_t*)(P.ws + OFF_GK); const bf16_t* GVT = (const bf16_t*)(P.ws + OFF_GVT); bf16_t* ST = (bf16_t*)(P.ws + OFF_ST);
    const float* w2 = P.gla_w_a2 + (size_t)j * 16 * 512; const float* ba = P.gla_b_a + j * 512;
    bf16_t* kdl = (bf16_t*)smem;
    float* decl = (float*)(smem + 4096);
    for (int u = vb; u < 256; u += nb) {
        const int b = u >> 5, hh = (u >> 3) & 3, ksl = u & 7;
        const int kc0 = hh * 128 + ksl * 16 + 2 * w;
        float wa[2][16], bb[2];
#pragma unroll
        for (int e = 0; e < 2; ++e) { bb[e] = ba[kc0 + e];
#pragma unroll
            for (int jj = 0; jj < 16; ++jj) wa[e][jj] = w2[jj * 512 + kc0 + e]; }
        f32x4 acc[2];
#pragma unroll
        for (int e = 0; e < 2; ++e) acc[e] = (f32x4){0.f, 0.f, 0.f, 0.f};
        __syncthreads();
        f32x4 a4n[4]; unsigned krawn; bf16x8 vfrn[2][2];
        auto ldchunk = [&](int n) {
            const int tok = b * 4096 + n * 64 + l;
#pragma unroll
            for (int q = 0; q < 4; ++q) a4n[q] = *(const f32x4*)(GA + (size_t)tok * 16 + 4 * q);
            krawn = *(const unsigned*)(GK + (size_t)tok * 512 + kc0);
#pragma unroll
            for (int e = 0; e < 2; ++e)
#pragma unroll
                for (int ks = 0; ks < 2; ++ks)
                    vfrn[e][ks] = *(const bf16x8*)(GVT + ((size_t)(b * 1024 + hh * 256 + (2 * w + e) * 16 + (l & 15))) * 4096 + n * 64 + ks * 32 + (l >> 4) * 8);
        };
        ldchunk(0);
        for (int n = 0; n < 64; ++n) {
            const int buf = n & 1;
            f32x4 a4[4]; bf16x8 vfr[2][2];
#pragma unroll
            for (int q = 0; q < 4; ++q) a4[q] = a4n[q];
            const unsigned kraw = krawn;
#pragma unroll
            for (int e = 0; e < 2; ++e)
#pragma unroll
                for (int ks = 0; ks < 2; ++ks) vfr[e][ks] = vfrn[e][ks];
            if (n + 1 < 64) ldchunk(n + 1);
            float cum[2];
#pragma unroll
            for (int e = 0; e < 2; ++e) {
                float z = bb[e];
#pragma unroll
                for (int q = 0; q < 4; ++q) { z += a4[q].x * wa[e][4 * q] + a4[q].y * wa[e][4 * q + 1] + a4[q].z * wa[e][4 * q + 2] + a4[q].w * wa[e][4 * q + 3]; }
                cum[e] = (fminf(z, 0.f) - __logf(1.f + __expf(-fabsf(z)))) * (1.f / 16.f);
            }
#pragma unroll
            for (int o = 1; o < 64; o <<= 1) {
                const float t0 = __shfl_up(cum[0], o), t1 = __shfl_up(cum[1], o);
                if (l >= o) { cum[0] += t0; cum[1] += t1; }
            }
            const float tot0 = __shfl(cum[0], 63), tot1 = __shfl(cum[1], 63);
            kdl[(buf * 16 + 2 * w) * 64 + l] = f2bf(bf2f(kraw & 0xffffu) * __expf(tot0 - cum[0]));
            kdl[(buf * 16 + 2 * w + 1) * 64 + l] = f2bf(bf2f(kraw >> 16) * __expf(tot1 - cum[1]));
            if (l == 0) { decl[buf * 16 + 2 * w] = __expf(tot0); decl[buf * 16 + 2 * w + 1] = __expf(tot1); }
            __syncthreads();
            const f32x4 d4 = *(const f32x4*)(decl + buf * 16 + (l >> 4) * 4);
#pragma unroll
            for (int e = 0; e < 2; ++e) acc[e] = acc[e] * d4;
#pragma unroll
            for (int ks = 0; ks < 2; ++ks) {
                const bf16x8 af = *(const bf16x8*)(kdl + (buf * 16 + (l & 15)) * 64 + ks * 32 + (l >> 4) * 8);
#pragma unroll
                for (int e = 0; e < 2; ++e) acc[e] = MFMA16(af, vfr[e][ks], acc[e]);
            }
            const int cidx = b * 64 + n;
#pragma unroll
            for (int e = 0; e < 2; ++e) {
                const int vv = (2 * w + e) * 16 + (l & 15);
                *(u32x2*)(ST + (((size_t)(cidx * 4 + hh)) * 256 + vv) * 128 + ksl * 16 + (l >> 4) * 4) = pk4(acc[e].x, acc[e].y, acc[e].z, acc[e].w);
            }
        }
    }
}

DI void ph_gla_out(const Params& P, int j, int vb, int nb, int tid, int dry = 0) {
    (void)dry;
    LANE_DECODE
    const bf16_t* GQ = (const bf16_t*)(P.ws + OFF_GQ); const bf16_t* ST = (const bf16_t*)(P.ws + OFF_ST); const bf16_t* GR = (const bf16_t*)(P.ws + OFF_GR); bf16_t* OG = (bf16_t*)(P.ws + OFF_OG);
    const float* on = P.gla_o_norm + j * 1024;
    f32x2* red = (f32x2*)smem;
    for (int u = vb; u < 2048; u += nb) {
        const int cidx = u >> 2, hh = u & 3, tok0 = cidx * 64;
        bf16x8 bfr[8], afr[2][8];
#pragma unroll
        for (int ks = 0; ks < 8; ++ks) {
            bfr[ks] = *(const bf16x8*)(ST + (((size_t)(cidx * 4 + hh)) * 256 + 32 * w + li) * 128 + ks * 16 + h * 8);
#pragma unroll
            for (int mi = 0; mi < 2; ++mi) afr[mi][ks] = *(const bf16x8*)(GQ + (size_t)(tok0 + mi * 32 + li) * 512 + hh * 128 + ks * 16 + h * 8);
        }
        f32x4 gn[4]; u32x2 rr[2][4];
#pragma unroll
        for (int g = 0; g < 4; ++g) {
            const int v0 = hh * 256 + 32 * w + 8 * g + 4 * h;
            gn[g] = *(const f32x4*)(on + v0);
#pragma unroll
            for (int mi = 0; mi < 2; ++mi) rr[mi][g] = *(const u32x2*)(GR + (size_t)(tok0 + mi * 32 + li) * 1024 + v0);
        }
        f32x16 acc[2];
#pragma unroll
        for (int mi = 0; mi < 2; ++mi)
#pragma unroll
            for (int i = 0; i < 16; ++i) acc[mi][i] = 0.f;
#pragma unroll
        for (int ks = 0; ks < 8; ++ks)
#pragma unroll
            for (int mi = 0; mi < 2; ++mi) acc[mi] = MFMA32(bfr[ks], afr[mi][ks], acc[mi]);
#pragma unroll
        for (int mi = 0; mi < 2; ++mi) {
            float s1 = 0.f, s2 = 0.f;
#pragma unroll
            for (int i = 0; i < 16; ++i) { s1 += acc[mi][i]; s2 += acc[mi][i] * acc[mi][i]; }
            s1 += __shfl_xor(s1, 32); s2 += __shfl_xor(s2, 32);
            if (h == 0) red[w * 64 + mi * 32 + li] = (f32x2){s1, s2};
        }
        __syncthreads();
#pragma unroll
        for (int mi = 0; mi < 2; ++mi) {
            float s1 = 0.f, s2 = 0.f;
#pragma unroll
            for (int ww = 0; ww < 8; ++ww) { const f32x2 t = red[ww * 64 + mi * 32 + li]; s1 += t.x; s2 += t.y; }
            const float mean = s1 * (1.f / 256.f), var = fmaxf(s2 * (1.f / 256.f) - mean * mean, 0.f), rstd = __builtin_amdgcn_rsqf(var + EPS);
            const int tok = tok0 + mi * 32 + li;
#pragma unroll
            for (int g = 0; g < 4; ++g) {
                const int v0 = hh * 256 + 32 * w + 8 * g + 4 * h;
                const u32x2 r2 = rr[mi][g];
                const float o0 = (acc[mi][4 * g] - mean) * rstd * gn[g].x * bf2f(r2.x & 0xffffu), o1 = (acc[mi][4 * g + 1] - mean) * rstd * gn[g].y * bf2f(r2.x >> 16);
                const float o2 = (acc[mi][4 * g + 2] - mean) * rstd * gn[g].z * bf2f(r2.y & 0xffffu), o3 = (acc[mi][4 * g + 3] - mean) * rstd * gn[g].w * bf2f(r2.y >> 16);
                *(u32x2*)(OG + (size_t)tok * 1024 + v0) = pk4(o0, o1, o2, o3);
            }
        }
        __syncthreads();
    }
}

#define XB_TMO      128
#define XB_XCNT(j)  (256  + 64 * (j))
#define XB_XSUB(j)  (1280 + 64 * (j))
#define XB_XGEN(j)  (2304 + 64 * (j))
#define XB_TOP      3328
#define XB_TOPGEN   3392
#define XCD_BAR_WORDS 3456
#define XB_SPIN_CAP (1u << 20)
#define LAS __attribute__((address_space(3)))
DI unsigned xb_ld(unsigned* p)              { return __hip_atomic_load(p, __ATOMIC_RELAXED, __HIP_MEMORY_SCOPE_AGENT); }
DI unsigned xb_add(unsigned* p, unsigned v) { return __hip_atomic_fetch_add(p, v, __ATOMIC_RELAXED, __HIP_MEMORY_SCOPE_AGENT); }
DI unsigned xb_xcc_id() { return (unsigned)__builtin_amdgcn_s_getreg((3 << 11) | 20) & 0xFu; }
#define XB_SPIN(cond, bar) do { unsigned _sp = 0; while (cond) { __builtin_amdgcn_s_sleep(1); \
    if ((++_sp & 255u) == 0u) { if (xb_ld(&(bar)[XB_TMO])) break; if (_sp > XB_SPIN_CAP) { atomicAdd(&(bar)[XB_TMO], 1u); break; } } } } while (0)
struct XcdBarrier { unsigned* bar; unsigned x; volatile LAS unsigned* st; };
DI XcdBarrier xcd_barrier_post(unsigned* bar, volatile LAS unsigned* st) {
    XcdBarrier b; b.bar = bar; b.x = xb_xcc_id(); b.st = st;
    if (threadIdx.x == 0) (void)xb_add(&bar[XB_XCNT(b.x)], 1u);
    return b;
}
DI void xcd_barrier_complete(unsigned* bar, unsigned x, unsigned& nloc, unsigned& nx) {
    const unsigned G = gridDim.x * gridDim.y * gridDim.z;
    unsigned sum, cnt, mine, sp = 0u;
    for (;;) {
        sum = 0u; cnt = 0u; mine = 0u;
#pragma unroll
        for (unsigned j = 0; j < 16; ++j) { const unsigned c = xb_ld(&bar[XB_XCNT(j)]); sum += c; cnt += (c > 0u) ? 1u : 0u; mine = (j == x) ? c : mine; }
        if (sum == G) break;
        __builtin_amdgcn_s_sleep(1);
        if ((++sp & 255u) == 0u) { if (xb_ld(&bar[XB_TMO])) break; if (sp > XB_SPIN_CAP) { atomicAdd(&bar[XB_TMO], 1u); break; } }
    }
    nloc = mine > 0u ? mine : 1u; nx = cnt > 0u ? cnt : 1u;
}
DI void xcd_barrier(const XcdBarrier& b) {
    asm volatile("s_waitcnt vmcnt(0)" ::: "memory");
    __syncthreads();
    if (threadIdx.x == 0) {
        unsigned* bar = b.bar;
        __builtin_amdgcn_s_waitcnt(0);
        unsigned nloc = b.st[0], nx = b.st[1];
        if (nloc == 0u) { xcd_barrier_complete(bar, b.x, nloc, nx); b.st[0] = nloc; b.st[1] = nx; }
        const unsigned old = xb_add(&bar[XB_XSUB(b.x)], 1u);
        const unsigned gen = old / nloc;
        if (old + 1u == (gen + 1u) * nloc) {
            __builtin_amdgcn_fence(__ATOMIC_RELEASE, "agent");
            asm volatile("s_waitcnt vmcnt(0)" ::: "memory");
            const unsigned og = xb_add(&bar[XB_TOP], 1u);
            const unsigned tg = og / nx;
            if (og + 1u == (tg + 1u) * nx) xb_add(&bar[XB_TOPGEN], 1u);
            else XB_SPIN(xb_ld(&bar[XB_TOPGEN]) == tg, bar);
            __builtin_amdgcn_fence(__ATOMIC_ACQUIRE, "agent");
            xb_add(&bar[XB_XGEN(b.x)], 1u);
            asm volatile("s_waitcnt vmcnt(0)" ::: "memory");
        } else {
            XB_SPIN(xb_ld(&bar[XB_XGEN(b.x)]) == gen, bar);
            __builtin_amdgcn_fence(__ATOMIC_ACQUIRE, "agent");
            asm volatile("s_waitcnt vmcnt(0)" ::: "memory");
        }
    }
    __syncthreads();
}

__global__ void __launch_bounds__(NTH) mega(Params P) {
    cg::grid_group grid = cg::this_grid();
    const int tid0 = threadIdx.x, nb = gridDim.x, bid = blockIdx.x;
    const int vb0 = ((nb & 7) == 0) ? (bid & 7) * (nb >> 3) + (bid >> 3) : bid;
    int ph = 0;
    const int lo = P.ph_lo, hi = P.ph_hi;
    __shared__ uint4 xb_words;
    if (tid0 == 0) xb_words = make_uint4(0u, 0u, 0u, 0u);
    __syncthreads();
    const XcdBarrier xb = xcd_barrier_post((unsigned*)(P.ws + OFF_BAR), (volatile LAS unsigned*)&xb_words);
#define GSYNC() { if (ph == 0) grid.sync(); else xcd_barrier(xb); }
#define PHASE1(body) { int tid = tid0, vb = vb0; asm volatile("" : "+v"(tid)); asm volatile("" : "+s"(vb)); body; }
#define PHASE(cls, fn, ...) { if (ph >= lo && ph < hi) { if ((PROBE_MASK >> cls) & 1) { PHASE1(fn(__VA_ARGS__, P.dry)) xcd_barrier(xb); } PHASE1(fn(__VA_ARGS__)) if (ph + 1 < hi) GSYNC() } ++ph; }
    if ((PROBE_MASK >> 11) & 1) { for (int i = 0; i < 50; ++i) xcd_barrier(xb); }
    PHASE(0, prologue, P, vb, nb, tid)
    for (int L = 0; L < 4; ++L) {
        const int j = L >> 1;
        const float* g1 = P.ln1_g + L * 1024; const float* b1 = P.ln1_b + L * 1024; const float* g2 = P.ln2_g + L * 1024; const float* b2 = P.ln2_b + L * 1024;
        if ((L & 1) == 0) {
            PHASE(1, ph_mla_in, P, j, vb, nb, tid)
            for (int half = 0; half < 2; ++half) {
                PHASE(1, ph_mla_up, P, j, half, vb, nb, tid)
                PHASE(2, ph_attn, P, half, vb, nb, tid)
                PHASE(3, (ph_res<1, false>), P, (const bf16_t*)(P.ws + OFF_Q), 3072, 2048, (const bf16_t*)(P.ws + OFF_WB) + WB_MLA + j * W_MLA_SZ + W_MLA_O, half * HALF_T, HALF_T, g1, b1, (L == 0 ? P.x : (const float*)P.out), vb, nb, tid)
            }
        } else {
            PHASE(1, ph_gla_in, P, j, vb, nb, tid)
            PHASE(9, ph_gla_scan, P, j, vb, nb, tid)
            PHASE(10, ph_gla_out, P, j, vb, nb, tid)
            PHASE(3, (ph_res<0, false>), P, (const bf16_t*)(P.ws + OFF_OG), 1024, 1024, (const bf16_t*)(P.ws + OFF_WB) + WB_GLA + j * W_GLA_SZ + W_GLA_O, 0, TT, g1, b1, (const float*)P.out, vb, nb, tid)
        }
        PHASE(4, ln_phase, P.out, (bf16_t*)(P.ws + OFF_XB), (f32x2*)(P.ws + OFF_STATS), g1, b1, vb, nb, tid)
        PHASE(5, ph_ffn_up, P, L, vb, nb, tid)
        PHASE(6, (ph_res<0, true>), P, (const bf16_t*)(P.ws + OFF_GATED), DFF, DFF, (const bf16_t*)(P.ws + OFF_WB) + WB_FFN + L * W_FFN_SZ + W_FFN_DN, 0, TT, g1, b1, (const float*)P.out, vb, nb, tid)
        PHASE(4, ln_phase, P.out, (bf16_t*)(P.ws + OFF_XB), (f32x2*)(P.ws + OFF_STATS), g2, b2, vb, nb, tid)
        PHASE(7, ph_ple, P, L, g2, b2, vb, nb, tid)
    }
}
constexpr int NPHASES = 1 + 2 * (1 + 6 + 5) + 2 * (4 + 5);

extern "C" void kernel_launch(void* const* d_in, const int* in_sizes, int n_in, void* d_out, int out_size, void* d_ws, size_t ws_size, hipStream_t stream) {
    static int grid_blocks = 0;
    if (!grid_blocks) {
        int dev = 0, cus = 0, per_cu = 0;
        hipGetDevice(&dev);
        hipDeviceGetAttribute(&cus, hipDeviceAttributeMultiprocessorCount, dev);
        hipFuncSetAttribute((const void*)mega, hipFuncAttributeMaxDynamicSharedMemorySize, LDS_BYTES);
        hipOccupancyMaxActiveBlocksPerMultiprocessor(&per_cu, (const void*)mega, NTH, LDS_BYTES);
        if (per_cu < 1) per_cu = 1;
        grid_blocks = cus * per_cu;
        if (grid_blocks > 256) grid_blocks = 256;
        if (ws_size < WS_NEED) fprintf(stderr, "kernel_launch: workspace too small: %zu < %zu\n", ws_size, (size_t)WS_NEED);
    }
    Params P{};
    P.x = (const float*)d_in[0]; P.p = (const float*)d_in[1]; P.pos = (const int*)d_in[2];
    P.mla_w_in = (const float*)d_in[3]; P.mla_q_norm = (const float*)d_in[4]; P.mla_kv_norm = (const float*)d_in[5]; P.mla_w_uq = (const float*)d_in[6];
    P.mla_w_uk = (const float*)d_in[7]; P.mla_w_uv = (const float*)d_in[8]; P.mla_w_o = (const float*)d_in[9];
    P.gla_w_in = (const float*)d_in[10]; P.gla_w_a2 = (const float*)d_in[11]; P.gla_b_a = (const float*)d_in[12]; P.gla_o_norm = (const float*)d_in[13]; P.gla_w_o = (const float*)d_in[14];
    P.ln1_g = (const float*)d_in[15]; P.ln1_b = (const float*)d_in[16]; P.ln2_g = (const float*)d_in[17]; P.ln2_b = (const float*)d_in[18];
    P.ffn_w_up = (const float*)d_in[19]; P.ffn_conv_w = (const float*)d_in[20]; P.ffn_conv_b = (const float*)d_in[21]; P.ffn_w_down = (const float*)d_in[22];
    P.ple_w_proj = (const float*)d_in[23]; P.ple_w_gate = (const float*)d_in[24]; P.ple_b_gate = (const float*)d_in[25];
    P.out = (float*)d_out; P.ws = (char*)d_ws;
    for (int i = 0; i < 32; ++i) P.invrev[i] = (1.0 / pow(10000.0, (double)(2 * i) / 64.0)) / (2.0 * M_PI);
#if MULTI_LAUNCH
    for (int ph = 0; ph < NPHASES; ++ph) {
        P.ph_lo = ph; P.ph_hi = ph + 1; P.dry = 1;
        hipLaunchKernelGGL(mega, dim3(grid_blocks), dim3(NTH), LDS_BYTES, stream, P);
    }
#else
    P.ph_lo = 0; P.ph_hi = NPHASES; P.dry = 1;
    (void)hipMemsetAsync((char*)d_ws + OFF_BAR, 0, 16384, stream);
    void* args[] = {&P};
    hipError_t e = hipLaunchCooperativeKernel((const void*)mega, dim3(grid_blocks), dim3(NTH), args, LDS_BYTES, stream);
    if (e != hipSuccess) fprintf(stderr, "cooperative launch failed: %s (grid %d)\n", hipGetErrorString(e), grid_blocks);
#endif
}
```

```cpp
#include <hip/hip_runtime.h>
#include <hip/hip_cooperative_groups.h>
#include <cstdio>
#include <cmath>
#include <type_traits>
namespace cg = cooperative_groups;

#ifndef MULTI_LAUNCH
#define MULTI_LAUNCH 0
#endif
#ifndef PROBE_MASK
#define PROBE_MASK 0
#endif

#define DI __device__ __forceinline__
typedef unsigned short bf16_t;
typedef short bf16x8 __attribute__((ext_vector_type(8)));
typedef float f32x16 __attribute__((ext_vector_type(16)));
typedef float f32x4 __attribute__((ext_vector_type(4)));
typedef float f32x2 __attribute__((ext_vector_type(2)));
typedef unsigned u32x4 __attribute__((ext_vector_type(4)));
typedef unsigned u32x2 __attribute__((ext_vector_type(2)));
typedef int i32x4 __attribute__((ext_vector_type(4)));
typedef __bf16 bf16x2_t __attribute__((ext_vector_type(2)));

#define MFMA32(a, b, c) __builtin_amdgcn_mfma_f32_32x32x16_bf16((a), (b), (c), 0, 0, 0)
#define MFMA16(a, b, c) __builtin_amdgcn_mfma_f32_16x16x32_bf16((a), (b), (c), 0, 0, 0)

DI unsigned pk2(float lo, float hi) { f32x2 v = {lo, hi}; return __builtin_bit_cast(unsigned, __builtin_convertvector(v, bf16x2_t)); }
DI bf16_t f2bf(float x) { return (bf16_t)(pk2(x, 0.f) & 0xffffu); }
DI float bf2f(unsigned x) { return __uint_as_float(x << 16); }
DI u32x2 pk4(float a, float b, float c, float d) { u32x2 r; r.x = pk2(a, b); r.y = pk2(c, d); return r; }
DI float fexp2(float x) { return __builtin_amdgcn_exp2f(x); }
DI float frcp(float x) { return __builtin_amdgcn_rcpf(x); }
DI float sigmoidf_(float x) { return frcp(1.f + fexp2(-1.44269504089f * x)); }
DI float gelu_tanh(float x) { const float t = __builtin_fmaf(x * x, -0.10294324f, -2.30220820f); return x * frcp(1.f + fexp2(t * x)); }

constexpr int TT = 32768, SS = 4096, DM = 1024;
constexpr int NTH = 512;
constexpr float DN_ALPHA = 1.6817928305074292f;
constexpr float EPS = 1e-5f;
constexpr int DFF = 2816;
constexpr int HALF_T = TT / 2;

constexpr size_t MiB = 1u << 20;
constexpr size_t OFF_WB = 0;
constexpr size_t OFF_COS = 116 * MiB, OFF_SIN = 120 * MiB, OFF_SSQ = 124 * MiB, OFF_KROPE = 126 * MiB, OFF_GA = 130 * MiB;
constexpr size_t OFF_CID = 132 * MiB, OFF_TMIN = OFF_CID + 256 * 1024, OFF_TMAX = OFF_TMIN + 4096;
constexpr size_t OFF_STATS = 133 * MiB;
constexpr size_t OFF_BAR = 134 * MiB;
constexpr size_t OFF_XB = 136 * MiB;
constexpr size_t OFF_H = 200 * MiB, OFF_Q = 248 * MiB, OFF_KN = 344 * MiB, OFF_VT = 408 * MiB;
constexpr size_t OFF_ST = 136 * MiB, OFF_GQ = 264 * MiB, OFF_GK = 296 * MiB, OFF_GVT = 328 * MiB, OFF_OG = 328 * MiB, OFF_GR = 392 * MiB;
constexpr size_t OFF_GATED = 200 * MiB;
constexpr size_t OFF_XBN_A = 200 * MiB, OFF_XBN_B = 392 * MiB;
constexpr size_t WS_NEED = 472 * MiB;

constexpr size_t W_MLA_IN = 0, W_MLA_UQ = W_MLA_IN + 896 * 1024, W_MLA_KV = W_MLA_UQ + 3072 * 512, W_MLA_O = W_MLA_KV + 4096 * 256, W_MLA_SZ = W_MLA_O + 1024 * 2048;
constexpr size_t W_GLA_IN = 0, W_GLA_O = W_GLA_IN + 3328 * 1024, W_GLA_SZ = W_GLA_O + 1024 * 1024;
constexpr size_t W_FFN_UP = 0, W_FFN_DN = W_FFN_UP + 5632 * 1024, W_FFN_SZ = W_FFN_DN + 1024 * 2816;
constexpr size_t W_PLE_G = 0, W_PLE_P = W_PLE_G + 1024 * 1024, W_PLE_SZ = W_PLE_P + 1024 * 256;
constexpr size_t WB_MLA = 0, WB_GLA = WB_MLA + 2 * W_MLA_SZ, WB_FFN = WB_GLA + 2 * W_GLA_SZ, WB_PLE = WB_FFN + 4 * W_FFN_SZ, WB_END = WB_PLE + 4 * W_PLE_SZ;
static_assert(WB_END * 2 <= 116 * MiB, "weight arena");

constexpr int G_STAGE = 49152, G_BOFF = 32768, XCH_OFF = 3 * G_STAGE, LDS_BYTES = XCH_OFF + 4096;
constexpr int AT_KB = 24576, AT_STAGE = 40960;

struct Params {
    const float* x; const float* p; const int* pos;
    const float *mla_w_in, *mla_q_norm, *mla_kv_norm, *mla_w_uq, *mla_w_uk, *mla_w_uv, *mla_w_o;
    const float *gla_w_in, *gla_w_a2, *gla_b_a, *gla_o_norm, *gla_w_o;
    const float *ln1_g, *ln1_b, *ln2_g, *ln2_b;
    const float *ffn_w_up, *ffn_conv_w, *ffn_conv_b, *ffn_w_down;
    const float *ple_w_proj, *ple_w_gate, *ple_b_gate;
    float* out; char* ws;
    double invrev[32];
    int ph_lo, ph_hi, dry, pad_;
};

extern __shared__ __attribute__((aligned(16))) char smem[];

template <bool AF32> struct AReg { u32x4 v[AF32 ? 8 : 4]; };
#define RAW_BARRIER() do { asm volatile("s_waitcnt lgkmcnt(0)" ::: "memory"); __builtin_amdgcn_s_barrier(); } while (0)

template <bool AF32, int AMODE, bool SWAP>
DI void mainloop_rs(f32x16 (&acc)[2][2], const void* Abase, int lda, int arow0, int amax, const bf16_t* Bbase, int ldb, int brow0, int nk, int tid) {
    const int l = tid & 63, w = tid >> 6, wr = w >> 1, wc = w & 1, h = l >> 5, li = l & 31;
    const int lc = tid & 7, lr = tid >> 3;
    const int st_off = lr * 128 + ((lc ^ ((lr >> 1) & 7)) << 4);
    const int lk = h ^ ((l >> 1) & 7);
    const int a_off = (wr * 64 + li) * 128, b_off = G_BOFF + (wc * 64 + li) * 128;
#pragma unroll
    for (int mi = 0; mi < 2; ++mi)
#pragma unroll
        for (int ni = 0; ni < 2; ++ni)
#pragma unroll
            for (int r = 0; r < 16; ++r) acc[mi][ni][r] = 0.f;
    AReg<AF32> ra; u32x4 rb[2];
    long arow[4];
#pragma unroll
    for (int i = 0; i < 4; ++i) { int row = arow0 + lr + 64 * i; row = row < 0 ? 0 : (row > amax ? amax : row); arow[i] = (long)row * lda + lc * 8; }
    const bf16_t* bp = Bbase + (long)(brow0 + lr) * ldb + lc * 8;
    auto gload = [&](int kt) {
        const int ka = (AMODE == 1) ? ((kt >> 1) * 192 + (kt & 1) * 64) : kt * 64;
#pragma unroll
        for (int i = 0; i < 4; ++i) {
            if (!AF32) ra.v[i] = *(const u32x4*)((const bf16_t*)Abase + arow[i] + ka);
            else { const float* p = (const float*)Abase + arow[i] + ka; ra.v[2 * i] = *(const u32x4*)p; ra.v[2 * i + 1] = *(const u32x4*)(p + 4); }
        }
#pragma unroll
        for (int i = 0; i < 2; ++i) rb[i] = *(const u32x4*)(bp + (long)(64 * i) * ldb + kt * 64);
    };
    auto lstore = [&](int s) {
        char* sb = smem + s * G_STAGE;
#pragma unroll
        for (int i = 0; i < 4; ++i) {
            u32x4 v;
            if (!AF32) v = ra.v[i];
            else { const u32x4 a = ra.v[2 * i], b = ra.v[2 * i + 1];
                v.x = pk2(__uint_as_float(a.x), __uint_as_float(a.y)); v.y = pk2(__uint_as_float(a.z), __uint_as_float(a.w));
                v.z = pk2(__uint_as_float(b.x), __uint_as_float(b.y)); v.w = pk2(__uint_as_float(b.z), __uint_as_float(b.w)); }
            *(u32x4*)(sb + st_off + i * 8192) = v;
        }
#pragma unroll
        for (int i = 0; i < 2; ++i) *(u32x4*)(sb + G_BOFF + st_off + i * 8192) = rb[i];
    };
    __syncthreads();
    gload(0); lstore(0); __syncthreads();
    for (int kt = 0; kt < nk; ++kt) {
        const bool more = kt + 1 < nk;
        if (more) gload(kt + 1);
        const char* sb = smem + (kt & 1) * G_STAGE;
#pragma unroll
        for (int ks = 0; ks < 4; ++ks) {
            const int co = (lk ^ (2 * ks)) << 4;
            bf16x8 a0 = *(const bf16x8*)(sb + a_off + co), a1 = *(const bf16x8*)(sb + a_off + 4096 + co);
            bf16x8 b0 = *(const bf16x8*)(sb + b_off + co), b1 = *(const bf16x8*)(sb + b_off + 4096 + co);
            if (!SWAP) { acc[0][0] = MFMA32(a0, b0, acc[0][0]); acc[0][1] = MFMA32(a0, b1, acc[0][1]); acc[1][0] = MFMA32(a1, b0, acc[1][0]); acc[1][1] = MFMA32(a1, b1, acc[1][1]); }
            else { acc[0][0] = MFMA32(b0, a0, acc[0][0]); acc[0][1] = MFMA32(b1, a0, acc[0][1]); acc[1][0] = MFMA32(b0, a1, acc[1][0]); acc[1][1] = MFMA32(b1, a1, acc[1][1]); }
        }
        if (more) lstore((kt + 1) & 1);
        __syncthreads();
    }
}

template <int MI> struct Cfg { static constexpr int NWC = (MI == 2 ? 2 : 4), BN = 64 * NWC, WROWS = 32 * MI, STAGE = (256 + BN) * 128, NBI = BN / 64; };
struct TD { const bf16_t* A; const bf16_t* B; int lda, ldb, arow0, amax, brow0, nk; };
DI TD mk_td(const bf16_t* A, int lda, int arow0, int amax, const bf16_t* B, int ldb, int brow0, int nk) { TD t; t.A = A; t.B = B; t.lda = lda; t.ldb = ldb; t.arow0 = arow0; t.amax = amax; t.brow0 = brow0; t.nk = nk; return t; }

template <int AMODE, bool SWAP, int MI>
DI void mainloop_dma(f32x16 (&acc)[MI][2], const TD& c, const TD& n, bool hasn, bool primed, int& s, int tid) {
    typedef Cfg<MI> C;
    const int l = tid & 63, w = tid >> 6, wr = w / C::NWC, wc = w % C::NWC, h = l >> 5, li = l & 31;
    const int lk = h ^ ((l >> 1) & 7);
    const int a_off = (wr * C::WROWS + li) * 128, b_off = G_BOFF + (wc * 64 + li) * 128;
    constexpr int NST = (MI == 2 ? 3 : 2);
#pragma unroll
    for (int mi = 0; mi < MI; ++mi)
#pragma unroll
        for (int ni = 0; ni < 2; ++ni)
#pragma unroll
            for (int r = 0; r < 16; ++r) acc[mi][ni][r] = 0.f;
    constexpr int NP = 4 + C::NBI;
    auto offs = [&](const TD& t, int (&ao)[4], int (&bo)[C::NBI]) {
#pragma unroll
        for (int i = 0; i < 4; ++i) {
            int row = t.arow0 + (4 * w + i) * 8 + (l >> 3); row = row < 0 ? 0 : (row > t.amax ? t.amax : row);
            ao[i] = row * t.lda + ((l & 7) ^ (((l >> 4) + 4 * (i & 1)) & 7)) * 8;
        }
#pragma unroll
        for (int i = 0; i < C::NBI; ++i) {
            const int row = t.brow0 + (C::NBI * w + i) * 8 + (l >> 3);
            bo[i] = row * t.ldb + ((l & 7) ^ (((l >> 4) + 4 * (i & 1)) & 7)) * 8;
        }
    };
    auto piece = [&](const TD& t, const int (&ao)[4], const int (&bo)[C::NBI], int kt, int st, int i) {
        char* sb = smem + st * C::STAGE;
        if (i < 4) {
            const int ka = (AMODE == 1) ? ((kt >> 1) * 192 + (kt & 1) * 64) : kt * 64;
            __builtin_amdgcn_global_load_lds((const __attribute__((address_space(1))) void*)(t.A + ka + ao[i]), (__attribute__((address_space(3))) void*)(sb + (4 * w + i) * 1024), 16, 0, 0);
        } else {
            __builtin_amdgcn_global_load_lds((const __attribute__((address_space(1))) void*)(t.B + kt * 64 + bo[i - 4]), (__attribute__((address_space(3))) void*)(sb + G_BOFF + (C::NBI * w + i - 4) * 1024), 16, 0, 0);
        }
    };
    int ao[4], bo[C::NBI];
    offs(c, ao, bo);
    const int nk = c.nk;
    if (!primed) {
        RAW_BARRIER();
        s = 0;
#pragma unroll
        for (int i = 0; i < NP; ++i) piece(c, ao, bo, 0, 0, i);
        if (MI == 2 && nk > 1) {
#pragma unroll
            for (int i = 0; i < NP; ++i) piece(c, ao, bo, 1, 1, i);
        }
    }
#pragma unroll 1
    for (int kt = 0; kt < nk; ++kt) {
        int ns, nkt;
        if (MI == 2) {
            if (kt + 1 < nk && kt > 0) asm volatile("s_waitcnt vmcnt(6)" ::: "memory"); else asm volatile("s_waitcnt vmcnt(0)" ::: "memory");
            RAW_BARRIER();
            ns = s >= 1 ? s - 1 : 2; nkt = kt + 2;
        } else {
            asm volatile("s_waitcnt vmcnt(0)" ::: "memory");
            RAW_BARRIER();
            ns = s ^ 1; nkt = kt + 1;
        }
        const bool doload = nkt < nk;
        const char* sb = smem + s * C::STAGE;
#pragma unroll
        for (int ks = 0; ks < 4; ++ks) {
            const int co = (lk ^ (2 * ks)) << 4;
            bf16x8 fa[MI], fb[2];
#pragma unroll
            for (int mi = 0; mi < MI; ++mi) fa[mi] = *(const bf16x8*)(sb + a_off + mi * 4096 + co);
            fb[0] = *(const bf16x8*)(sb + b_off + co); fb[1] = *(const bf16x8*)(sb + b_off + 4096 + co);
            asm volatile("" ::: "memory");
            if (doload) {
                constexpr int P0[5] = {0, (NP + 3) / 4, (NP + 3) / 4 + (NP + 2) / 4, (NP + 3) / 4 + (NP + 2) / 4 + (NP + 1) / 4, NP};
#pragma unroll
                for (int i = P0[ks]; i < P0[ks + 1]; ++i) piece(c, ao, bo, nkt, ns, i);
            }
            asm volatile("" ::: "memory");
#pragma unroll
            for (int mi = 0; mi < MI; ++mi)
#pragma unroll
                for (int ni = 0; ni < 2; ++ni) {
                    if (!SWAP) acc[mi][ni] = MFMA32(fa[mi], fb[ni], acc[mi][ni]);
                    else acc[mi][ni] = MFMA32(fb[ni], fa[mi], acc[mi][ni]);
                }
        }
        s = (s + 1 == NST) ? 0 : s + 1;
    }
    if (hasn) {
        offs(n, ao, bo);
#pragma unroll
        for (int i = 0; i < NP; ++i) piece(n, ao, bo, 0, s, i);
        if (MI == 2 && n.nk > 1) {
            const int s1 = (s + 1 == NST) ? 0 : s + 1;
#pragma unroll
            for (int i = 0; i < NP; ++i) piece(n, ao, bo, 1, s1, i);
        }
    }
}

template <int AMODE, bool SWAPO = true>
DI void mainloop_dma16(f32x4 (&acc)[4][2][2][2], const TD& c, const TD& n, bool hasn, bool primed, int& s, int tid) {
    constexpr int MI = 4; typedef Cfg<MI> C;
    const int l = tid & 63, w = tid >> 6, wr = w / C::NWC, wc = w % C::NWC, r16 = l & 15, q = l >> 4;
    const int key = (l >> 1) & 7;
    const int a_off = (wr * C::WROWS + r16) * 128, b_off = G_BOFF + (wc * 64 + r16) * 128;
#pragma unroll
    for (int mi = 0; mi < MI; ++mi)
#pragma unroll
        for (int ni = 0; ni < 2; ++ni)
#pragma unroll
            for (int rh = 0; rh < 2; ++rh)
#pragma unroll
                for (int ch = 0; ch < 2; ++ch) acc[mi][ni][rh][ch] = (f32x4){0.f, 0.f, 0.f, 0.f};
    constexpr int NP = 4 + C::NBI;
    auto offs = [&](const TD& t, int (&ao)[4], int (&bo)[C::NBI]) {
#pragma unroll
        for (int i = 0; i < 4; ++i) {
            int row = t.arow0 + (4 * w + i) * 8 + (l >> 3); row = row < 0 ? 0 : (row > t.amax ? t.amax : row);
            ao[i] = row * t.lda + ((l & 7) ^ (((l >> 4) + 4 * (i & 1)) & 7)) * 8;
        }
#pragma unroll
        for (int i = 0; i < C::NBI; ++i) {
            const int row = t.brow0 + (C::NBI * w + i) * 8 + (l >> 3);
            bo[i] = row * t.ldb + ((l & 7) ^ (((l >> 4) + 4 * (i & 1)) & 7)) * 8;
        }
    };
    auto piece = [&](const TD& t, const int (&ao)[4], const int (&bo)[C::NBI], int kt, int st, int i) {
        char* sb = smem + st * C::STAGE;
        if (i < 4) {
            const int ka = (AMODE == 1) ? ((kt >> 1) * 192 + (kt & 1) * 64) : kt * 64;
            __builtin_amdgcn_global_load_lds((const __attribute__((address_space(1))) void*)(t.A + ka + ao[i]), (__attribute__((address_space(3))) void*)(sb + (4 * w + i) * 1024), 16, 0, 0);
        } else {
            __builtin_amdgcn_global_load_lds((const __attribute__((address_space(1))) void*)(t.B + kt * 64 + bo[i - 4]), (__attribute__((address_space(3))) void*)(sb + G_BOFF + (C::NBI * w + i - 4) * 1024), 16, 0, 0);
        }
    };
    int ao[4], bo[C::NBI];
    offs(c, ao, bo);
    const int nk = c.nk;
    if (!primed) {
        RAW_BARRIER();
        s = 0;
#pragma unroll
        for (int i = 0; i < NP; ++i) piece(c, ao, bo, 0, 0, i);
    }
#pragma unroll 1
    for (int kt = 0; kt < nk; ++kt) {
        asm volatile("s_waitcnt vmcnt(0)" ::: "memory");
        RAW_BARRIER();
        const int ns = s ^ 1, nkt = kt + 1;
        const bool doload = nkt < nk;
        const char* sb = smem + s * C::STAGE;
#pragma unroll
        for (int k2 = 0; k2 < 2; ++k2) {
            const int co = ((4 * k2 + q) ^ key) << 4;
            bf16x8 fw[2][2];
#pragma unroll
            for (int ni = 0; ni < 2; ++ni)
#pragma unroll
                for (int rh = 0; rh < 2; ++rh) fw[ni][rh] = *(const bf16x8*)(sb + b_off + (ni * 32 + rh * 16) * 128 + co);
#pragma unroll
            for (int mh = 0; mh < 2; ++mh) {
                bf16x8 fx[2][2];
#pragma unroll
                for (int m2 = 0; m2 < 2; ++m2)
#pragma unroll
                    for (int ch = 0; ch < 2; ++ch) fx[m2][ch] = *(const bf16x8*)(sb + a_off + ((2 * mh + m2) * 32 + ch * 16) * 128 + co);
                asm volatile("" ::: "memory");
                if (doload) { const int p0 = (2 * k2 + mh) * 2; piece(c, ao, bo, nkt, ns, p0); piece(c, ao, bo, nkt, ns, p0 + 1); }
                asm volatile("" ::: "memory");
#pragma unroll
                for (int m2 = 0; m2 < 2; ++m2)
#pragma unroll
                    for (int ni = 0; ni < 2; ++ni)
#pragma unroll
                        for (int rh = 0; rh < 2; ++rh)
#pragma unroll
                            for (int ch = 0; ch < 2; ++ch)
                                acc[2 * mh + m2][ni][rh][ch] = SWAPO ? MFMA16(fw[ni][rh], fx[m2][ch], acc[2 * mh + m2][ni][rh][ch]) : MFMA16(fx[m2][ch], fw[ni][rh], acc[2 * mh + m2][ni][rh][ch]);
            }
        }
        s ^= 1;
    }
    if (hasn) {
        offs(n, ao, bo);
#pragma unroll
        for (int i = 0; i < NP; ++i) piece(n, ao, bo, 0, s, i);
    }
}

template <bool AF32, int AMODE, bool SWAP>
DI void mainloop(f32x16 (&acc)[2][2], const void* Abase, int lda, int arow0, int amax, const bf16_t* Bbase, int ldb, int brow0, int nk, int tid) {
    if constexpr (AF32) mainloop_rs<AF32, AMODE, SWAP>(acc, Abase, lda, arow0, amax, Bbase, ldb, brow0, nk, tid);
    else { int st = 0; const TD c = mk_td((const bf16_t*)Abase, lda, arow0, amax, Bbase, ldb, brow0, nk); mainloop_dma<AMODE, SWAP, 2>(acc, c, c, false, false, st, tid); }
}

DI void convT(const float* __restrict__ src, int K, int N, bf16_t* __restrict__ dst, int Npad, int mode, const float* __restrict__ gain, int vb, int nb, int& base, int tid) {
    float* tile = (float*)smem;
    const int nkt = K >> 6, ntiles = nkt * (Npad >> 6);
    int t0 = (vb - (base % nb) + nb) % nb;
    for (int t = t0; t < ntiles; t += nb) {
        const int kt = t % nkt, ntile = t / nkt, k0 = kt * 64, n0 = ntile * 64;
#pragma unroll
        for (int i = 0; i < 8; ++i) {
            const int k = (tid >> 6) + 8 * i, n = tid & 63, gn = n0 + n;
            float v = 0.f;
            if (gn < N) { v = src[(long)(k0 + k) * N + gn]; if (gain) v *= gain[k0 + k]; }
            tile[k * 65 + n] = v;
        }
        __syncthreads();
#pragma unroll
        for (int i = 0; i < 8; ++i) {
            const int n = (tid >> 6) + 8 * i, k = tid & 63, gn = n0 + n;
            int row = gn;
            if (mode == 1) { const int sub = gn >= DFF ? 1 : 0, c = gn - sub * DFF; row = (c >> 5) * 64 + sub * 32 + (c & 31); }
            dst[(long)row * K + k0 + k] = f2bf(tile[k * 65 + n]);
        }
        __syncthreads();
    }
    base += ntiles;
}

DI float wave_sum(float v) {
#pragma unroll
    for (int o = 32; o >= 1; o >>= 1) v += __shfl_xor(v, o);
    return v;
}

DI void prologue(const Params& P, int vb, int nb, int tid, int dry = 0) {
    (void)dry;
    bf16_t* WB = (bf16_t*)(P.ws + OFF_WB);
    int base = 0;
    for (int j = 0; j < 2; ++j) {
        bf16_t* wm = WB + WB_MLA + j * W_MLA_SZ;
        convT(P.mla_w_in + (size_t)j * 1024 * 832, 1024, 832, wm + W_MLA_IN, 896, 0, nullptr, vb, nb, base, tid);
        convT(P.mla_w_uq + (size_t)j * 512 * 3072, 512, 3072, wm + W_MLA_UQ, 3072, 0, P.mla_q_norm + j * 512, vb, nb, base, tid);
        convT(P.mla_w_uk + (size_t)j * 256 * 2048, 256, 2048, wm + W_MLA_KV, 2048, 0, P.mla_kv_norm + j * 256, vb, nb, base, tid);
        convT(P.mla_w_uv + (size_t)j * 256 * 2048, 256, 2048, wm + W_MLA_KV + 2048 * 256, 2048, 0, P.mla_kv_norm + j * 256, vb, nb, base, tid);
        convT(P.mla_w_o + (size_t)j * 2048 * 1024, 2048, 1024, wm + W_MLA_O, 1024, 0, nullptr, vb, nb, base, tid);
        bf16_t* wg = WB + WB_GLA + j * W_GLA_SZ;
        convT(P.gla_w_in + (size_t)j * 1024 * 3088, 1024, 3088, wg + W_GLA_IN, 3328, 0, nullptr, vb, nb, base, tid);
        convT(P.gla_w_o + (size_t)j * 1024 * 1024, 1024, 1024, wg + W_GLA_O, 1024, 0, nullptr, vb, nb, base, tid);
    }
    for (int i = 0; i < 4; ++i) {
        bf16_t* wf = WB + WB_FFN + i * W_FFN_SZ;
        convT(P.ffn_w_up + (size_t)i * 1024 * 5632, 1024, 5632, wf + W_FFN_UP, 5632, 1, nullptr, vb, nb, base, tid);
        convT(P.ffn_w_down + (size_t)i * 2816 * 1024, 2816, 1024, wf + W_FFN_DN, 1024, 0, nullptr, vb, nb, base, tid);
        bf16_t* wp = WB + WB_PLE + i * W_PLE_SZ;
        convT(P.ple_w_gate + (size_t)i * 1024 * 1024, 1024, 1024, wp + W_PLE_G, 1024, 0, nullptr, vb, nb, base, tid);
        convT(P.ple_w_proj + (size_t)i * 256 * 1024, 256, 1024, wp + W_PLE_P, 1024, 0, nullptr, vb, nb, base, tid);
    }
    {
        const f32x4* xs = (const f32x4*)P.x; f32x4* xo = (f32x4*)P.out; u32x2* xb = (u32x2*)(P.ws + OFF_XB);
        const int n4 = TT * DM / 4;
        for (int i = vb * NTH + tid; i < n4; i += nb * NTH) { f32x4 v = xs[i]; xb[i] = pk4(v.x, v.y, v.z, v.w); }
        (void)xo;
    }
    {
        float* COS = (float*)(P.ws + OFF_COS); float* SIN = (float*)(P.ws + OFF_SIN);
        for (int i = vb * NTH + tid; i < TT * 32; i += nb * NTH) {
            const int t = i >> 5, f = i & 31;
            double rev = (double)P.pos[t] * P.invrev[f];
            rev -= rint(rev);
            const float fr = (float)rev;
            COS[i] = __builtin_amdgcn_cosf(fr); SIN[i] = __builtin_amdgcn_sinf(fr);
        }
    }
    {
        int* CID = (int*)(P.ws + OFF_CID); int* TMIN = (int*)(P.ws + OFF_TMIN); int* TMAX = (int*)(P.ws + OFF_TMAX);
        const int l = tid & 63, w = tid >> 6;
        for (int tl = vb * 8 + w; tl < TT / 64; tl += nb * 8) {
            const int c = P.pos[tl * 64 + l] >> 6;
            CID[tl * 64 + l] = c;
            int mn = c, mx = c;
#pragma unroll
            for (int o = 32; o >= 1; o >>= 1) { mn = min(mn, __shfl_xor(mn, o)); mx = max(mx, __shfl_xor(mx, o)); }
            if (l == 0) { TMIN[tl] = mn; TMAX[tl] = mx; }
        }
    }
}

DI void ln_phase(const float* X32, bf16_t* Xb, f32x2* STATS, const float* __restrict__ g, const float* __restrict__ b, int vb, int nb, int tid, int dry = 0) {
    const int l = tid & 63, w = tid >> 6;
    f32x4 gg[4], bb[4];
#pragma unroll
    for (int j = 0; j < 4; ++j) { gg[j] = ((const f32x4*)g)[l + 64 * j]; bb[j] = ((const f32x4*)b)[l + 64 * j]; }
    const int stride = nb * 8;
    for (int row = vb * 8 + w; row < TT; row += 2 * stride) {
        const int row2 = row + stride; const bool has2 = row2 < TT;
        const f32x4* xr = (const f32x4*)(X32 + (size_t)row * DM); const f32x4* xr2 = (const f32x4*)(X32 + (size_t)(has2 ? row2 : row) * DM);
        f32x4 v[4], u[4]; float s = 0.f, t = 0.f;
#pragma unroll
        for (int j = 0; j < 4; ++j) { v[j] = xr[l + 64 * j]; u[j] = xr2[l + 64 * j]; }
#pragma unroll
        for (int j = 0; j < 4; ++j) { s += (v[j].x + v[j].y) + (v[j].z + v[j].w); t += (u[j].x + u[j].y) + (u[j].z + u[j].w); }
        const float mean = wave_sum(s) * (1.f / DM), mean2 = wave_sum(t) * (1.f / DM); float s2 = 0.f, t2 = 0.f;
#pragma unroll
        for (int j = 0; j < 4; ++j) { v[j] = v[j] - mean; u[j] = u[j] - mean2; s2 += (v[j].x * v[j].x + v[j].y * v[j].y) + (v[j].z * v[j].z + v[j].w * v[j].w); t2 += (u[j].x * u[j].x + u[j].y * u[j].y) + (u[j].z * u[j].z + u[j].w * u[j].w); }
        const float rstd = __builtin_amdgcn_rsqf(wave_sum(s2) * (1.f / DM) + EPS), rstd2 = __builtin_amdgcn_rsqf(wave_sum(t2) * (1.f / DM) + EPS);
        if (!dry) {
            u32x2* xb = (u32x2*)(Xb + (size_t)row * DM);
            if (l == 0) STATS[row] = (f32x2){mean, rstd};
#pragma unroll
            for (int j = 0; j < 4; ++j) { f32x4 o = v[j] * rstd * gg[j] + bb[j]; xb[l + 64 * j] = pk4(o.x, o.y, o.z, o.w); }
            if (has2) {
                u32x2* xb2 = (u32x2*)(Xb + (size_t)row2 * DM);
                if (l == 0) STATS[row2] = (f32x2){mean2, rstd2};
#pragma unroll
                for (int j = 0; j < 4; ++j) { f32x4 o = u[j] * rstd2 * gg[j] + bb[j]; xb2[l + 64 * j] = pk4(o.x, o.y, o.z, o.w); }
            }
        }
    }
}

#define LAUNDER_TID int tid_e = tid; asm volatile("" : "+v"(tid_e));
#define LANE_DECODE_E(MI_) const int l = tid_e & 63, w = tid_e >> 6, wr = w / Cfg<MI_>::NWC, wc = w % Cfg<MI_>::NWC, h = l >> 5, li = l & 31; (void)l; (void)w; (void)wr; (void)wc; (void)h; (void)li;
#define LANE_DECODE_T(MI_) const int l = tid & 63, w = tid >> 6, wr = w / Cfg<MI_>::NWC, wc = w % Cfg<MI_>::NWC, h = l >> 5, li = l & 31; (void)l; (void)w; (void)wr; (void)wc; (void)h; (void)li;
#define LANE_DECODE const int l = tid & 63, w = tid >> 6, wr = w >> 1, wc = w & 1, h = l >> 5, li = l & 31; (void)l; (void)w; (void)wr; (void)wc; (void)h; (void)li;

template <class F>
DI void wave_rows_store(char* buf, int l, bf16_t* grow0, size_t ld, F vals) {
    const int li = l & 31, h = l >> 5;
#pragma unroll
    for (int ni = 0; ni < 2; ++ni)
#pragma unroll
        for (int g = 0; g < 4; ++g) *(u32x2*)(buf + li * 144 + ni * 64 + g * 16 + h * 8) = vals(ni, g);
#pragma unroll
    for (int jj = 0; jj < 4; ++jj) {
        const int row = (l >> 3) + 8 * jj;
        const u32x4 v = *(const u32x4*)(buf + row * 144 + (l & 7) * 16);
        *(u32x4*)(grow0 + (size_t)row * ld + (l & 7) * 8) = v;
    }
}

template <class F>
DI void wave_rows_store16(char* buf, int l, bf16_t* grow0, size_t ld, F vals) {
    const int r16 = l & 15, q = l >> 4;
#pragma unroll
    for (int ni = 0; ni < 2; ++ni)
#pragma unroll
        for (int rh = 0; rh < 2; ++rh) *(u32x2*)(buf + r16 * 144 + (ni * 32 + rh * 16 + 4 * q) * 2) = vals(ni, rh);
#pragma unroll
    for (int jj = 0; jj < 2; ++jj) {
        const int row = (l >> 3) + 8 * jj;
        const u32x4 v = *(const u32x4*)(buf + row * 144 + (l & 7) * 16);
        *(u32x4*)(grow0 + (size_t)row * ld + (l & 7) * 8) = v;
    }
}

DI void ph_mla_in(const Params& P, int j, int vb, int nb, int tid, int dry = 0) {
    (void)dry;
    LANE_DECODE
    const bf16_t* Xb = (const bf16_t*)(P.ws + (j == 0 ? OFF_XB : OFF_XBN_B)); const bf16_t* W = (const bf16_t*)(P.ws + OFF_WB) + WB_MLA + j * W_MLA_SZ + W_MLA_IN;
    bf16_t* H = (bf16_t*)(P.ws + OFF_H); float* SSQ = (float*)(P.ws + OFF_SSQ); bf16_t* KR = (bf16_t*)(P.ws + OFF_KROPE);
    const float* COS = (const float*)(P.ws + OFF_COS); const float* SIN = (const float*)(P.ws + OFF_SIN);
    constexpr int NT = 7, MT = TT / 256;
    auto td = [&](int tile) { return mk_td(Xb, DM, (tile / NT) * 256, TT - 1, W, 1024, (tile % NT) * 128, 16); };
    constexpr int NTILES_ = MT * NT; int stg = 0; bool primed = false;
    for (int tile = vb; tile < MT * NT; tile += nb) {
        const int mt = tile / NT, nt = tile % NT;
        f32x16 acc[2][2];
        { const TD c_ = td(tile); const bool hn_ = tile + nb < NTILES_; const TD n_ = td(hn_ ? tile + nb : tile); mainloop_dma<0, true, 2>(acc, c_, n_, hn_, primed, stg, tid); primed = hn_; }
        const int wt = nt * 2 + wc;
        if (wt < 12) {
#pragma unroll
            for (int mi = 0; mi < 2; ++mi) {
                const int tok = mt * 256 + wr * 64 + mi * 32 + li; float ss = 0.f;
#pragma unroll
                for (int ni = 0; ni < 2; ++ni)
#pragma unroll
                    for (int g = 0; g < 4; ++g) {
                        const float a = acc[mi][ni][4 * g], b = acc[mi][ni][4 * g + 1], c = acc[mi][ni][4 * g + 2], d = acc[mi][ni][4 * g + 3];
                        ss += (a * a + b * b) + (c * c + d * d);
                        *(u32x2*)(H + (size_t)tok * 768 + wt * 64 + ni * 32 + 8 * g + 4 * h) = pk4(a, b, c, d);
                    }
                ss += __shfl_xor(ss, 32);
                if (h == 0) SSQ[tok * 12 + wt] = ss;
            }
        } else if (wt == 12) {
#pragma unroll
            for (int mi = 0; mi < 2; ++mi) {
                const int tok = mt * 256 + wr * 64 + mi * 32 + li;
#pragma unroll
                for (int g = 0; g < 4; ++g) {
                    const int i0 = 8 * g + 4 * h;
                    const f32x4 c4 = *(const f32x4*)(COS + tok * 32 + i0), s4 = *(const f32x4*)(SIN + tok * 32 + i0);
                    float o1[4], o2[4];
#pragma unroll
                    for (int c = 0; c < 4; ++c) { const float x1 = acc[mi][0][4 * g + c], x2 = acc[mi][1][4 * g + c]; o1[c] = x1 * c4[c] - x2 * s4[c]; o2[c] = x1 * s4[c] + x2 * c4[c]; }
                    *(u32x2*)(KR + (size_t)tok * 64 + i0) = pk4(o1[0], o1[1], o1[2], o1[3]);
                    *(u32x2*)(KR + (size_t)tok * 64 + 32 + i0) = pk4(o2[0], o2[1], o2[2], o2[3]);
                }
            }
        }
    }
}

DI void ph_mla_up(const Params& P, int j, int half, int vb, int nb, int tid, int dry = 0) {
    (void)dry;
    constexpr int MI = 4; typedef Cfg<MI> C;
    const bf16_t* H = (const bf16_t*)(P.ws + OFF_H); const float* SSQ = (const float*)(P.ws + OFF_SSQ);
    const bf16_t* WQ = (const bf16_t*)(P.ws + OFF_WB) + WB_MLA + j * W_MLA_SZ + W_MLA_UQ; const bf16_t* WKV = (const bf16_t*)(P.ws + OFF_WB) + WB_MLA + j * W_MLA_SZ + W_MLA_KV;
    bf16_t* Q = (bf16_t*)(P.ws + OFF_Q); bf16_t* KN = (bf16_t*)(P.ws + OFF_KN); bf16_t* VT = (bf16_t*)(P.ws + OFF_VT);
    const float* COS = (const float*)(P.ws + OFF_COS); const float* SIN = (const float*)(P.ws + OFF_SIN);
    constexpr int MT = HALF_T / 256, NTQ = 3072 / C::BN, NTKV = 4096 / C::BN, TQ = MT * NTQ, TKV = MT * NTKV;
    const float QSCALE = 0.07216878364870322f * 1.4426950408889634f;
    auto td = [&](int tile) {
        if (tile < TQ) return mk_td(H, 768, half * HALF_T + (tile / NTQ) * 256, TT - 1, WQ, 512, (tile % NTQ) * C::BN, 8);
        const int t2 = tile - TQ; return mk_td(H + 512, 768, half * HALF_T + (t2 / NTKV) * 256, TT - 1, WKV, 256, (t2 % NTKV) * C::BN, 4);
    };
    constexpr int NTILES_ = TQ + TKV; int stg = 0; bool primed = false;
    for (int tile = vb; tile < TQ + TKV; tile += nb) {
        f32x16 acc[MI][2];
        { const TD c_ = td(tile); const bool hn_ = tile + nb < NTILES_; const TD n_ = td(hn_ ? tile + nb : tile); mainloop_dma<0, true, MI>(acc, c_, n_, hn_, primed, stg, tid); primed = hn_; }
        LAUNDER_TID LANE_DECODE_E(MI)
        __syncthreads();
        char* ebuf = smem + (stg ^ 1) * C::STAGE + w * 4608;
        if (tile < TQ) {
            const int mt = tile / NTQ, nt = tile % NTQ, tok0 = half * HALF_T + mt * 256;
            const int wt = nt * C::NWC + wc, head = wt / 3, part = wt - head * 3;
#pragma unroll
            for (int mi = 0; mi < MI; ++mi) {
                const int tok = tok0 + wr * C::WROWS + mi * 32 + li, tl = tok - half * HALF_T;
                const f32x4 s0 = *(const f32x4*)(SSQ + tok * 12), s1 = *(const f32x4*)(SSQ + tok * 12 + 4);
                const float rs = __builtin_amdgcn_rsqf(((s0.x + s0.y) + (s0.z + s0.w) + (s1.x + s1.y) + (s1.z + s1.w)) * (1.f / 512.f) + EPS) * QSCALE;
                bf16_t* dst = Q + (size_t)tl * 3072 + head * 192 + part * 64;
                bf16_t* drow0 = Q + (size_t)(tok0 - half * HALF_T + wr * C::WROWS + mi * 32) * 3072 + head * 192 + part * 64;
                if (part < 2) {
                    wave_rows_store(ebuf, l, drow0, 3072, [&](int ni, int g) { return pk4(acc[mi][ni][4 * g] * rs, acc[mi][ni][4 * g + 1] * rs, acc[mi][ni][4 * g + 2] * rs, acc[mi][ni][4 * g + 3] * rs); });
                } else {
#pragma unroll
                    for (int g = 0; g < 4; ++g) {
                        const int i0 = 8 * g + 4 * h;
                        const f32x4 c4 = *(const f32x4*)(COS + tok * 32 + i0), s4 = *(const f32x4*)(SIN + tok * 32 + i0);
                        float o1[4], o2[4];
#pragma unroll
                        for (int c = 0; c < 4; ++c) { const float x1 = acc[mi][0][4 * g + c] * rs, x2 = acc[mi][1][4 * g + c] * rs; o1[c] = x1 * c4[c] - x2 * s4[c]; o2[c] = x1 * s4[c] + x2 * c4[c]; }
                        *(u32x2*)(dst + i0) = pk4(o1[0], o1[1], o1[2], o1[3]);
                        *(u32x2*)(dst + 32 + i0) = pk4(o2[0], o2[1], o2[2], o2[3]);
                    }
                }
            }
        } else {
            const int t2 = tile - TQ, mt = t2 / NTKV, nt = t2 % NTKV, tok0 = half * HALF_T + mt * 256;
            const int ncol0 = nt * C::BN + wc * 64;
#pragma unroll
            for (int mi = 0; mi < MI; ++mi) {
                const int tok = tok0 + wr * C::WROWS + mi * 32 + li, tl = tok - half * HALF_T;
                const f32x4 s0 = *(const f32x4*)(SSQ + tok * 12 + 8);
                const float rs = __builtin_amdgcn_rsqf(((s0.x + s0.y) + (s0.z + s0.w)) * (1.f / 256.f) + EPS);
                if (ncol0 < 2048) {
                    wave_rows_store(ebuf, l, KN + (size_t)(tok0 - half * HALF_T + wr * C::WROWS + mi * 32) * 2048 + ncol0, 2048,
                                    [&](int ni, int g) { return pk4(acc[mi][ni][4 * g] * rs, acc[mi][ni][4 * g + 1] * rs, acc[mi][ni][4 * g + 2] * rs, acc[mi][ni][4 * g + 3] * rs); });
                } else {
                    const int bl = tl >> 12, sq = tl & 4095;
#pragma unroll
                    for (int ni = 0; ni < 2; ++ni)
#pragma unroll
                        for (int r = 0; r < 16; ++r) {
                            const int n = ncol0 - 2048 + ni * 32 + 8 * (r >> 2) + 4 * h + (r & 3);
                            VT[((size_t)(bl * 2048 + n)) * 4096 + sq] = f2bf(acc[mi][ni][r] * rs);
                        }
                }
            }
        }
    }
}

template <int AMODE, bool PEND>
DI void ph_res(const Params& P, const bf16_t* A, int lda, int K, const bf16_t* W, int tokbase, int ntok, const float* lg, const float* lb, const float* Xsrc, int vb, int nb, int tid, int dry = 0) {
    constexpr int MI = 4; typedef Cfg<MI> C;
    float* X32 = P.out;
    const int MT = ntok / 256; constexpr int NT = 1024 / C::BN;
    auto td = [&](int tile) { return mk_td(A, lda, (tile / NT) * 256, ntok - 1, W, K, (tile % NT) * C::BN, K / 64); };
    const int NTILES_ = MT * NT; int stg = 0; bool primed = false;
    for (int tile = vb; tile < MT * NT; tile += nb) {
        const int mt = tile / NT, nt = tile % NT;
        f32x4 acc[MI][2][2][2];
        { const TD c_ = td(tile); const bool hn_ = tile + nb < NTILES_; const TD n_ = td(hn_ ? tile + nb : tile); mainloop_dma16<AMODE>(acc, c_, n_, hn_, primed, stg, tid); primed = hn_; }
        int tid_e = tid; asm volatile("" : "+v"(tid_e));
        const int l = tid_e & 63, w = tid_e >> 6, wr = w / C::NWC, wc = w % C::NWC, r16 = l & 15, q = l >> 4;
        const int colb = nt * C::BN + wc * 64 + 4 * q;
        f32x4 g4[2][2], b4[2][2];
        if (PEND) {
#pragma unroll
            for (int ni = 0; ni < 2; ++ni)
#pragma unroll
                for (int rh = 0; rh < 2; ++rh) { g4[ni][rh] = *(const f32x4*)(lg + colb + ni * 32 + rh * 16); b4[ni][rh] = *(const f32x4*)(lb + colb + ni * 32 + rh * 16); }
        }
        const int tokb = tokbase + mt * 256 + wr * C::WROWS + r16;
        f32x4 nx[2][2]; f32x2 nst = {0.f, 1.f};
        auto ldgrp = [&](int grp) {
            const int tok = tokb + (grp >> 1) * 32 + (grp & 1) * 16;
            if (PEND) nst = ((const f32x2*)(P.ws + OFF_STATS))[tok];
#pragma unroll
            for (int ni = 0; ni < 2; ++ni)
#pragma unroll
                for (int rh = 0; rh < 2; ++rh) nx[ni][rh] = *(const f32x4*)(Xsrc + (size_t)tok * DM + colb + ni * 32 + rh * 16);
        };
        ldgrp(0);
#pragma unroll
        for (int grp = 0; grp < 8; ++grp) {
            const int mi = grp >> 1, ch = grp & 1, tok = tokb + mi * 32 + ch * 16;
            f32x4 o[2][2]; const f32x2 st = nst;
#pragma unroll
            for (int ni = 0; ni < 2; ++ni)
#pragma unroll
                for (int rh = 0; rh < 2; ++rh) o[ni][rh] = nx[ni][rh];
            if (grp + 1 < 8) ldgrp(grp + 1);
#pragma unroll
            for (int ni = 0; ni < 2; ++ni)
#pragma unroll
                for (int rh = 0; rh < 2; ++rh) {
                    f32x4 v = o[ni][rh];
                    if (PEND) v = (v - st.x) * st.y * g4[ni][rh] + b4[ni][rh];
                    v = v * DN_ALPHA + acc[mi][ni][rh][ch];
                    if (!dry) *(f32x4*)(X32 + (size_t)tok * DM + colb + ni * 32 + rh * 16) = v;
                }
        }
    }
}

DI void ph_gla_in(const Params& P, int j, int vb, int nb, int tid, int dry = 0) {
    (void)dry;
    constexpr int MI = 4; typedef Cfg<MI> C;
    const bf16_t* Xb = (const bf16_t*)(P.ws + OFF_XBN_A); const bf16_t* W = (const bf16_t*)(P.ws + OFF_WB) + WB_GLA + j * W_GLA_SZ + W_GLA_IN;
    bf16_t* GQ = (bf16_t*)(P.ws + OFF_GQ); bf16_t* GK = (bf16_t*)(P.ws + OFF_GK); bf16_t* GVT = (bf16_t*)(P.ws + OFF_GVT); bf16_t* GR = (bf16_t*)(P.ws + OFF_GR); float* GA = (float*)(P.ws + OFF_GA);
    constexpr int NT = 13, MT = TT / 256;
    auto td = [&](int tile) { return mk_td(Xb, DM, (tile / NT) * 256, TT - 1, W, 1024, (tile % NT) * C::BN, 16); };
    constexpr int NTILES_ = MT * NT; int stg = 0; bool primed = false;
    for (int tile = vb; tile < MT * NT; tile += nb) {
        const int mt = tile / NT, nt = tile % NT;
        f32x4 acc[MI][2][2][2];
        const bool vtile = nt >= 4 && nt < 8;
        { const TD c_ = td(tile); const bool hn_ = tile + nb < NTILES_; const TD n_ = td(hn_ ? tile + nb : tile);
          if (vtile) mainloop_dma16<0, false>(acc, c_, n_, hn_, primed, stg, tid); else mainloop_dma16<0, true>(acc, c_, n_, hn_, primed, stg, tid);
          primed = hn_; }
        int tid_e = tid; asm volatile("" : "+v"(tid_e));
        const int l = tid_e & 63, w = tid_e >> 6, wr = w / C::NWC, wc = w % C::NWC, r16 = l & 15, q = l >> 4;
        __syncthreads();
        char* ebuf = smem + (stg ^ 1) * C::STAGE + w * 2304;
        if (vtile) {
#pragma unroll
            for (int mi = 0; mi < MI; ++mi)
#pragma unroll
                for (int ch = 0; ch < 2; ++ch) {
                    const int tok = mt * 256 + wr * C::WROWS + mi * 32 + ch * 16 + 4 * q, bb = tok >> 12, sq = tok & 4095;
#pragma unroll
                    for (int ni = 0; ni < 2; ++ni)
#pragma unroll
                        for (int rh = 0; rh < 2; ++rh) {
                            const int n = (nt * C::BN + wc * 64 - 1024) + ni * 32 + rh * 16 + r16;
                            const f32x4 v = acc[mi][ni][rh][ch];
                            *(u32x2*)(GVT + ((size_t)(bb * 1024 + n)) * 4096 + sq) = pk4(v.x, v.y, v.z, v.w);
                        }
                }
            continue;
        }
        const int wt = nt * C::NWC + wc;
#pragma unroll
        for (int mi = 0; mi < MI; ++mi)
#pragma unroll
            for (int ch = 0; ch < 2; ++ch) {
                const int tok = mt * 256 + wr * C::WROWS + mi * 32 + ch * 16 + r16;
                if (wt < 16) {
                    bf16_t* dst0 = (wt < 8 ? GQ + wt * 64 : GK + (wt - 8) * 64) + (size_t)(tok - r16) * 512;
                    const float sc = wt < 8 ? 0.08838834764831845f : 1.f;
                    wave_rows_store16(ebuf, l, dst0, 512, [&](int ni, int rh) { const f32x4 v = acc[mi][ni][rh][ch] * sc; return pk4(v.x, v.y, v.z, v.w); });
                } else if (wt < 32) {
                    const int bb = tok >> 12, sq = tok & 4095;
#pragma unroll
                    for (int ni = 0; ni < 2; ++ni)
#pragma unroll
                        for (int rh = 0; rh < 2; ++rh)
#pragma unroll
                            for (int r = 0; r < 4; ++r) {
                                const int n = (wt - 16) * 64 + ni * 32 + rh * 16 + 4 * q + r;
                                GVT[((size_t)(bb * 1024 + n)) * 4096 + sq] = f2bf(acc[mi][ni][rh][ch][r]);
                            }
                } else if (wt < 48) {
                    bf16_t* dst0 = GR + (size_t)(tok - r16) * 1024 + (wt - 32) * 64;
                    wave_rows_store16(ebuf, l, dst0, 1024, [&](int ni, int rh) { const f32x4 x = acc[mi][ni][rh][ch]; return pk4(x.x * sigmoidf_(x.x), x.y * sigmoidf_(x.y), x.z * sigmoidf_(x.z), x.w * sigmoidf_(x.w)); });
                } else if (wt == 48) {
                    *(f32x4*)(GA + (size_t)tok * 16 + 4 * q) = acc[mi][0][0][ch];
                }
            }
    }
}

DI void ph_ffn_up(const Params& P, int L, int vb, int nb, int tid, int dry = 0) {
    (void)dry;
    constexpr int MI = 4; typedef Cfg<MI> C;
    const bf16_t* Xb = (const bf16_t*)(P.ws + OFF_XB); const bf16_t* W = (const bf16_t*)(P.ws + OFF_WB) + WB_FFN + L * W_FFN_SZ + W_FFN_UP;
    bf16_t* GT = (bf16_t*)(P.ws + OFF_GATED);
    const float* cw = P.ffn_conv_w + (size_t)L * 3 * 5632; const float* cb = P.ffn_conv_b + (size_t)L * 5632;
    float* xch = (float*)(smem + XCH_OFF);
    constexpr int NT = 5632 / C::BN, MT = (TT + 253) / 254;
    auto tmap = [&](int lin, int& mt, int& nt) { const int panel = lin / (MT * 4), within = lin - panel * (MT * 4), pw = (NT - panel * 4) < 4 ? (NT - panel * 4) : 4; mt = within / pw; nt = panel * 4 + within % pw; };
    auto td = [&](int lin) { int mt, nt; tmap(lin, mt, nt); return mk_td(Xb, DM, mt * 254 - 2, TT - 1, W, 1024, nt * C::BN, 16); };
    constexpr int NTILES_ = MT * NT; int stg = 0; bool primed = false;
    for (int tile = vb; tile < MT * NT; tile += nb) {
        int mt, nt; tmap(tile, mt, nt);
        f32x4 acc[MI][2][2][2];
        { const TD c_ = td(tile); const bool hn_ = tile + nb < NTILES_; const TD n_ = td(hn_ ? tile + nb : tile); mainloop_dma16<0, false>(acc, c_, n_, hn_, primed, stg, tid); primed = hn_; }
        int tid_e = tid; asm volatile("" : "+v"(tid_e));
        const int l = tid_e & 63, w = tid_e >> 6, wr = w / C::NWC, wc = w % C::NWC, r16 = l & 15, q = l >> 4;
        const int wv = wr * C::NWC + wc, rot = (l + 48) & 63;
        if (q == 3) {
#pragma unroll
            for (int ug = 0; ug < 2; ++ug)
#pragma unroll
                for (int rh = 0; rh < 2; ++rh) {
                    xch[((((wv * 2 + 0) * 2 + ug) * 2 + rh) << 4) + r16] = acc[MI - 1][ug][rh][1][2];
                    xch[((((wv * 2 + 1) * 2 + ug) * 2 + rh) << 4) + r16] = acc[MI - 1][ug][rh][1][3];
                }
        }
        float wka[2][2][3], bka[2][2];
#pragma unroll
        for (int rh = 0; rh < 2; ++rh)
#pragma unroll
            for (int ug = 0; ug < 2; ++ug) {
                const int col = ug * DFF + (nt * C::NWC + wc) * 32 + rh * 16 + r16;
                wka[rh][ug][0] = cw[col]; wka[rh][ug][1] = cw[5632 + col]; wka[rh][ug][2] = cw[2 * 5632 + col]; bka[rh][ug] = cb[col];
            }
        asm volatile("s_waitcnt vmcnt(0)" ::: "memory");
        __syncthreads();
        const int tlo = (mt * 254 - 2) < 0 ? 0 : (mt * 254 - 2), rlo = tlo & 4095;
        const bool has_start = (rlo <= 1) || (rlo + 256 > 4096);
        auto epi = [&](auto padc) {
        constexpr bool PAD = decltype(padc)::value;
#pragma unroll
        for (int rh = 0; rh < 2; ++rh) {
            const int cu = (nt * C::NWC + wc) * 32 + rh * 16 + r16;
            float wk[2][3], bk[2], c2[2], c3[2];
#pragma unroll
            for (int ug = 0; ug < 2; ++ug) {
                wk[ug][0] = wka[rh][ug][0]; wk[ug][1] = wka[rh][ug][1]; wk[ug][2] = wka[rh][ug][2]; bk[ug] = bka[rh][ug];
                c2[ug] = wr > 0 ? xch[(((((wv - C::NWC) * 2 + 0) * 2 + ug) * 2 + rh) << 4) + r16] : 0.f;
                c3[ug] = wr > 0 ? xch[(((((wv - C::NWC) * 2 + 1) * 2 + ug) * 2 + rh) << 4) + r16] : 0.f;
            }
#pragma unroll
            for (int mi = 0; mi < MI; ++mi)
#pragma unroll
                for (int ch = 0; ch < 2; ++ch) {
                    const int i0 = wr * C::WROWS + mi * 32 + ch * 16 + 4 * q;
                    const int t0 = mt * 254 - 2 + i0;
                    float y[2][4];
#pragma unroll
                    for (int ug = 0; ug < 2; ++ug) {
                        const f32x4 x = acc[mi][ug][rh][ch];
                        const float r2 = __shfl(x[2], rot), r3 = __shfl(x[3], rot);
                        const float pm2 = q ? r2 : c2[ug], pm1 = q ? r3 : c3[ug];
                        c2[ug] = r2; c3[ug] = r3;
                        const float vals[6] = {pm2, pm1, x[0], x[1], x[2], x[3]};
#pragma unroll
                        for (int c = 0; c < 4; ++c) {
                            const int sq = (t0 + c) & 4095;
                            const float t1 = (!PAD || sq >= 1) ? vals[c + 1] : 0.f, t2 = (!PAD || sq >= 2) ? vals[c] : 0.f;
                            y[ug][c] = __builtin_fmaf(wk[ug][0], t2, __builtin_fmaf(wk[ug][1], t1, __builtin_fmaf(wk[ug][2], vals[c + 2], bk[ug])));
                        }
                    }
                    const int goff = t0 * DFF + cu;
                    if (mt < MT - 1 && (mi | ch) != 0) {
#pragma unroll
                        for (int c = 0; c < 4; ++c) GT[goff + c * DFF] = f2bf(y[0][c] * gelu_tanh(y[1][c]));
                    } else {
#pragma unroll
                        for (int c = 0; c < 4; ++c) {
                            const int t = t0 + c;
                            if (i0 + c >= 2 && t < TT) GT[goff + c * DFF] = f2bf(y[0][c] * gelu_tanh(y[1][c]));
                        }
                    }
                }
        }
        };
        if (has_start) epi(std::true_type{}); else epi(std::false_type{});
    }
}

DI void ph_ple(const Params& P, int L, const float* lg, const float* lb, int vb, int nb, int tid, int dry = 0) {
    LANE_DECODE
    const bf16_t* Xbc = (const bf16_t*)(P.ws + OFF_XB); bf16_t* Xb = (bf16_t*)(P.ws + OFF_XB);
    const bf16_t* WG = (const bf16_t*)(P.ws + OFF_WB) + WB_PLE + L * W_PLE_SZ + W_PLE_G; const bf16_t* WP = (const bf16_t*)(P.ws + OFF_WB) + WB_PLE + L * W_PLE_SZ + W_PLE_P;
    const float* pp = P.p + (size_t)L * TT * 256; const float* bg = P.ple_b_gate + L * 1024;
    float* X32 = P.out;
    constexpr int NT = 8, MT = TT / 256;
    bf16_t* XB2 = (bf16_t*)(P.ws + ((L & 1) ? OFF_XBN_B : OFF_XBN_A));
    for (int tile = vb; tile < MT * NT; tile += nb) {
        const int mt = tile / NT, nt = tile % NT;
        f32x16 accg[2][2];
        unsigned pp2[2][2][8];
        {
            f32x16 accp[2][2];
            mainloop<true, 0, true>(accp, pp, 256, mt * 256, TT - 1, WP, 256, nt * 128, 4, tid);
#pragma unroll
            for (int mi = 0; mi < 2; ++mi)
#pragma unroll
                for (int ni = 0; ni < 2; ++ni)
#pragma unroll
                    for (int q = 0; q < 8; ++q) pp2[mi][ni][q] = pk2(accp[mi][ni][2 * q], accp[mi][ni][2 * q + 1]);
        }
        mainloop<false, 0, true>(accg, Xbc, DM, mt * 256, TT - 1, WG, 1024, nt * 128, 16, tid);
        const int tokA = mt * 256 + wr * 64 + li;
        f32x2 st2[2];
#pragma unroll
        for (int mi = 0; mi < 2; ++mi) st2[mi] = ((const f32x2*)(P.ws + OFF_STATS))[tokA + mi * 32];
        const int colq = nt * 128 + wc * 64 + 4 * h;
        f32x4 nb4, ng4, nl4, nx[2];
        auto ldq = [&](int k) {
            const int col = colq + (k >> 2) * 32 + (k & 3) * 8;
            nb4 = *(const f32x4*)(bg + col); ng4 = *(const f32x4*)(lg + col); nl4 = *(const f32x4*)(lb + col);
#pragma unroll
            for (int mi = 0; mi < 2; ++mi) nx[mi] = *(const f32x4*)(X32 + (size_t)(tokA + mi * 32) * DM + col);
        };
        ldq(0);
#pragma unroll
        for (int k = 0; k < 8; ++k) {
            const int ni = k >> 2, g = k & 3, col = colq + ni * 32 + g * 8;
            const f32x4 b4 = nb4, g4 = ng4, bl4 = nl4; f32x4 xo[2];
#pragma unroll
            for (int mi = 0; mi < 2; ++mi) xo[mi] = nx[mi];
            if (k + 1 < 8) ldq(k + 1);
#pragma unroll
            for (int mi = 0; mi < 2; ++mi) {
                const unsigned p01 = pp2[mi][ni][2 * g], p23 = pp2[mi][ni][2 * g + 1];
                f32x4 o = (xo[mi] - st2[mi].x) * st2[mi].y * g4 + bl4;
                o.x += sigmoidf_(accg[mi][ni][4 * g] + b4.x) * bf2f(p01 & 0xffffu);
                o.y += sigmoidf_(accg[mi][ni][4 * g + 1] + b4.y) * bf2f(p01 >> 16);
                o.z += sigmoidf_(accg[mi][ni][4 * g + 2] + b4.z) * bf2f(p23 & 0xffffu);
                o.w += sigmoidf_(accg[mi][ni][4 * g + 3] + b4.w) * bf2f(p23 >> 16);
                if (!dry) { *(f32x4*)(X32 + (size_t)(tokA + mi * 32) * DM + col) = o; *(u32x2*)(XB2 + (size_t)(tokA + mi * 32) * DM + col) = pk4(o.x, o.y, o.z, o.w); }
            }
        }
    }
    (void)Xb;
}

DI void ph_copy_xb(const Params& P, int vb, int nb, int tid, int dry = 0) {
    (void)dry;
    const u32x4* s = (const u32x4*)(P.ws + OFF_GATED); u32x4* d = (u32x4*)(P.ws + OFF_XB);
    const int n = TT * DM / 8;
    for (int i = vb * NTH + tid; i < n; i += nb * NTH) d[i] = s[i];
}

DI void ph_attn(const Params& P, int half, int vb, int nb, int tid, int dry = 0) {
    const int l = tid & 63, w = tid >> 6, r16 = l & 15, qq = l >> 4;
    bf16_t* Q = (bf16_t*)(P.ws + OFF_Q); const bf16_t* KN = (const bf16_t*)(P.ws + OFF_KN); const bf16_t* VT = (const bf16_t*)(P.ws + OFF_VT); const bf16_t* KR = (const bf16_t*)(P.ws + OFF_KROPE);
    const int* CID = (const int*)(P.ws + OFF_CID); const int* TMIN = (const int*)(P.ws + OFF_TMIN); const int* TMAX = (const int*)(P.ws + OFF_TMAX);
    const int krow0 = 8 * (r16 >> 2) + (r16 & 3);
    const int kkey = 2 * ((r16 >> 1) & 1) + 4 * ((r16 >> 3) & 1);
    const int vkey = (r16 >> 1) & 7;
    for (int u = vb; u < 1024; u += nb) {
        const int r = u >> 8, v = u & 255, xcd = v >> 5, slot = v & 31, gq = slot & 3, rw = (r + ((slot >> 2) & 3)) & 3;
        const int bh = xcd * 8 + 2 * r + (slot >> 4), bl = bh >> 4, head = bh & 15;
        const int qt = (rw == 0) ? 15 - gq : (rw == 1) ? 8 + gq : (rw == 2) ? 7 - gq : gq;
        const int q0 = qt * 256, nkt = 4 * qt + 4;
        const int tlb = bl * 4096, gtb = half * HALF_T + tlb;
        const int qs0 = q0 + w * 32 + r16;
        bf16x8 qf[6][2];
#pragma unroll
        for (int ds = 0; ds < 6; ++ds)
#pragma unroll
            for (int qb = 0; qb < 2; ++qb) qf[ds][qb] = *(const bf16x8*)(Q + (size_t)(tlb + qs0 + 16 * qb) * 3072 + head * 192 + ds * 32 + qq * 8);
        int tminq = TMIN[(gtb + q0) >> 6];
#pragma unroll
        for (int i = 1; i < 4; ++i) tminq = min(tminq, TMIN[((gtb + q0) >> 6) + i]);
        float m[2] = {-1e30f, -1e30f}, lsum[2] = {0.f, 0.f};
        f32x4 ao[8][2];
#pragma unroll
        for (int d = 0; d < 8; ++d)
#pragma unroll
            for (int qb = 0; qb < 2; ++qb) ao[d][qb] = (f32x4){0.f, 0.f, 0.f, 0.f};
        unsigned koff[3], kst[3], voff[2];
#pragma unroll
        for (int i = 0; i < 3; ++i) {
            const int bb = 1024 * (3 * w + i) + 16 * l, rw = bb / 384, pc = (bb - 384 * rw) >> 4, c = (pc & 24) | ((pc ^ (2 * ((rw >> 1) & 1) + 4 * ((rw >> 4) & 1))) & 7);
            if (c < 16) { koff[i] = (unsigned)(OFF_KN + ((size_t)(tlb + rw) * 2048 + head * 128 + c * 8) * 2); kst[i] = 64 * 2048 * 2; }
            else { koff[i] = (unsigned)(OFF_KROPE + ((size_t)(gtb + rw) * 64 + (c - 16) * 8) * 2); kst[i] = 64 * 64 * 2; }
        }
#pragma unroll
        for (int i = 0; i < 2; ++i) {
            const int row = 8 * (2 * w + i) + (l >> 3), c = (l & 7) ^ ((row >> 1) & 7);
            voff[i] = (unsigned)(OFF_VT + (((size_t)(bl * 2048 + head * 128 + row)) * 4096 + c * 8) * 2);
        }
        auto issue_k = [&](int kt, int st) {
            char* sb = smem + st * AT_STAGE;
#pragma unroll
            for (int i = 0; i < 3; ++i)
                __builtin_amdgcn_global_load_lds((const __attribute__((address_space(1))) void*)(P.ws + (koff[i] + (unsigned)kt * kst[i])), (__attribute__((address_space(3))) void*)(sb + (3 * w + i) * 1024), 16, 0, 0);
        };
        auto issue_v = [&](int kt, int st) {
            char* sb = smem + st * AT_STAGE;
#pragma unroll
            for (int i = 0; i < 2; ++i)
                __builtin_amdgcn_global_load_lds((const __attribute__((address_space(1))) void*)(P.ws + (voff[i] + (unsigned)kt * 128u)), (__attribute__((address_space(3))) void*)(sb + AT_KB + (2 * w + i) * 1024), 16, 0, 0);
        };
        auto issue = [&](int kt, int st) { issue_k(kt, st); issue_v(kt, st); };
        __syncthreads();
        issue(0, 0); asm volatile("s_waitcnt vmcnt(0)" ::: "memory"); __syncthreads();
        for (int kt = 0; kt < nkt; ++kt) {
            const bool more = kt + 1 < nkt;
            if (more) issue_k(kt + 1, (kt + 1) & 1);
            const char* sb = smem + (kt & 1) * AT_STAGE;
            f32x4 as[4][2];
#pragma unroll
            for (int kb = 0; kb < 4; ++kb)
#pragma unroll
                for (int qb = 0; qb < 2; ++qb) as[kb][qb] = (f32x4){0.f, 0.f, 0.f, 0.f};
#pragma unroll
            for (int ds = 0; ds < 6; ++ds) {
                const int ch = 4 * ds + qq;
#pragma unroll
                for (int kb = 0; kb < 4; ++kb) {
                    const int krow = krow0 + 32 * (kb >> 1) + 4 * (kb & 1), key = kkey;
                    const bf16x8 kf = *(const bf16x8*)(sb + krow * 384 + (((ch & 24) | ((ch ^ key) & 7)) << 4));
#pragma unroll
                    for (int qb = 0; qb < 2; ++qb) as[kb][qb] = MFMA16(kf, qf[ds][qb], as[kb][qb]);
                }
            }
            const bool need_mask = (kt >= 4 * qt) || (TMAX[((gtb) >> 6) + kt] > tminq);
            if (need_mask) {
#pragma unroll
                for (int qb = 0; qb < 2; ++qb) {
                    const int qsr = qs0 + 16 * qb, cidq = CID[gtb + qsr], q1lim = ((qsr >> 7) + 1) << 7;
#pragma unroll
                    for (int k2 = 0; k2 < 2; ++k2) {
                        const int kbase = kt * 64 + 32 * k2 + 8 * qq;
                        const i32x4 c0 = *(const i32x4*)(CID + gtb + kbase), c1 = *(const i32x4*)(CID + gtb + kbase + 4);
#pragma unroll
                        for (int rr = 0; rr < 4; ++rr) {
                            if (!((kbase + rr < q1lim) && (c0[rr] <= cidq))) as[2 * k2][qb][rr] = -1e30f;
                            if (!((kbase + 4 + rr < q1lim) && (c1[rr] <= cidq))) as[2 * k2 + 1][qb][rr] = -1e30f;
                        }
                    }
                }
            }
            float alpha[2];
#pragma unroll
            for (int qb = 0; qb < 2; ++qb) {
                float mx = as[0][qb][0];
#pragma unroll
                for (int kb = 0; kb < 4; ++kb)
#pragma unroll
                    for (int rr = 0; rr < 4; ++rr) mx = fmaxf(mx, as[kb][qb][rr]);
                mx = fmaxf(mx, __shfl_xor(mx, 16)); mx = fmaxf(mx, __shfl_xor(mx, 32));
                const float mnew = fmaxf(m[qb], mx);
                alpha[qb] = fexp2(m[qb] - mnew); m[qb] = mnew;
                float ps = 0.f;
#pragma unroll
                for (int kb = 0; kb < 4; ++kb)
#pragma unroll
                    for (int rr = 0; rr < 4; ++rr) { const float pv = fexp2(as[kb][qb][rr] - mnew); as[kb][qb][rr] = pv; ps += pv; }
                lsum[qb] = lsum[qb] * alpha[qb] + ps;
            }
            if (__builtin_amdgcn_ballot_w64(alpha[0] != 1.f || alpha[1] != 1.f) != 0ull) {
#pragma unroll
                for (int d = 0; d < 8; ++d)
#pragma unroll
                    for (int qb = 0; qb < 2; ++qb) ao[d][qb] = ao[d][qb] * alpha[qb];
            }
            if (more) issue_v(kt + 1, (kt + 1) & 1);
            bf16x8 pf[2][2];
#pragma unroll
            for (int k2 = 0; k2 < 2; ++k2)
#pragma unroll
                for (int qb = 0; qb < 2; ++qb) {
                    u32x4 pkd;
                    pkd.x = pk2(as[2 * k2][qb][0], as[2 * k2][qb][1]); pkd.y = pk2(as[2 * k2][qb][2], as[2 * k2][qb][3]);
                    pkd.z = pk2(as[2 * k2 + 1][qb][0], as[2 * k2 + 1][qb][1]); pkd.w = pk2(as[2 * k2 + 1][qb][2], as[2 * k2 + 1][qb][3]);
                    pf[k2][qb] = __builtin_bit_cast(bf16x8, pkd);
                }
#pragma unroll
            for (int k2 = 0; k2 < 2; ++k2) {
                const int ph = ((4 * k2 + qq) ^ vkey) << 4;
#pragma unroll
                for (int d = 0; d < 8; ++d) {
                    const bf16x8 vf = *(const bf16x8*)(sb + AT_KB + (d * 16 + r16) * 128 + ph);
#pragma unroll
                    for (int qb = 0; qb < 2; ++qb) ao[d][qb] = MFMA16(vf, pf[k2][qb], ao[d][qb]);
                }
            }
            asm volatile("s_waitcnt vmcnt(0)" ::: "memory");
            __syncthreads();
        }
        if (!dry) {
#pragma unroll
            for (int qb = 0; qb < 2; ++qb) {
                float ls = lsum[qb]; ls += __shfl_xor(ls, 16); ls += __shfl_xor(ls, 32);
                const float inv = frcp(ls);
                bf16_t* orow = Q + (size_t)(tlb + qs0 + 16 * qb) * 3072 + head * 192 + 4 * qq;
#pragma unroll
                for (int d = 0; d < 8; ++d) { const f32x4 o = ao[d][qb] * inv; *(u32x2*)(orow + d * 16) = pk4(o.x, o.y, o.z, o.w); }
            }
        }
    }
}

DI void ph_gla_scan(const Params& P, int j, int vb, int nb, int tid, int dry = 0) {
    (void)dry;
    const int l = tid & 63, w = tid >> 6;
    const float* GA = (const float*)(P.ws + OFF_GA); const bf16_t* GK = (const bf16_t*)(P.ws + OFF_GK); const bf16_t* GVT = (const bf16_t*)(P.ws + OFF_GVT); bf16_t* ST = (bf16_t*)(P.ws + OFF_ST);
    const float* w2 = P.gla_w_a2 + (size_t)j * 16 * 512; const float* ba = P.gla_b_a + j * 512;
    bf16_t* kdl = (bf16_t*)smem;
    float* decl = (float*)(smem + 4096);
    for (int u = vb; u < 256; u += nb) {
        const int b = u >> 5, hh = (u >> 3) & 3, ksl = u & 7;
        const int kc0 = hh * 128 + ksl * 16 + 2 * w;
        float wa[2][16], bb[2];
#pragma unroll
        for (int e = 0; e < 2; ++e) { bb[e] = ba[kc0 + e];
#pragma unroll
            for (int jj = 0; jj < 16; ++jj) wa[e][jj] = w2[jj * 512 + kc0 + e]; }
        f32x4 acc[2];
#pragma unroll
        for (int e = 0; e < 2; ++e) acc[e] = (f32x4){0.f, 0.f, 0.f, 0.f};
        __syncthreads();
        f32x4 a4n[4]; unsigned krawn; bf16x8 vfrn[2][2];
        auto ldchunk = [&](int n) {
            const int tok = b * 4096 + n * 64 + l;
#pragma unroll
            for (int q = 0; q < 4; ++q) a4n[q] = *(const f32x4*)(GA + (size_t)tok * 16 + 4 * q);
            krawn = *(const unsigned*)(GK + (size_t)tok * 512 + kc0);
#pragma unroll
            for (int e = 0; e < 2; ++e)
#pragma unroll
                for (int ks = 0; ks < 2; ++ks)
                    vfrn[e][ks] = *(const bf16x8*)(GVT + ((size_t)(b * 1024 + hh * 256 + (2 * w + e) * 16 + (l & 15))) * 4096 + n * 64 + ks * 32 + (l >> 4) * 8);
        };
        ldchunk(0);
        for (int n = 0; n < 64; ++n) {
            const int buf = n & 1;
            f32x4 a4[4]; bf16x8 vfr[2][2];
#pragma unroll
            for (int q = 0; q < 4; ++q) a4[q] = a4n[q];
            const unsigned kraw = krawn;
#pragma unroll
            for (int e = 0; e < 2; ++e)
#pragma unroll
                for (int ks = 0; ks < 2; ++ks) vfr[e][ks] = vfrn[e][ks];
            if (n + 1 < 64) ldchunk(n + 1);
            float cum[2];
#pragma unroll
            for (int e = 0; e < 2; ++e) {
                float z = bb[e];
#pragma unroll
                for (int q = 0; q < 4; ++q) { z += a4[q].x * wa[e][4 * q] + a4[q].y * wa[e][4 * q + 1] + a4[q].z * wa[e][4 * q + 2] + a4[q].w * wa[e][4 * q + 3]; }
                cum[e] = (fminf(z, 0.f) - __logf(1.f + __expf(-fabsf(z)))) * (1.f / 16.f);
            }
#pragma unroll
            for (int o = 1; o < 64; o <<= 1) {
                const float t0 = __shfl_up(cum[0], o), t1 = __shfl_up(cum[1], o);
                if (l >= o) { cum[0] += t0; cum[1] += t1; }
            }
            const float tot0 = __shfl(cum[0], 63), tot1 = __shfl(cum[1], 63);
            kdl[(buf * 16 + 2 * w) * 64 + l] = f2bf(bf2f(kraw & 0xffffu) * __expf(tot0 - cum[0]));
            kdl[(buf * 16 + 2 * w + 1) * 64 + l] = f2bf(bf2f(kraw >> 16) * __expf(tot1 - cum[1]));
            if (l == 0) { decl[buf * 16 + 2 * w] = __expf(tot0); decl[buf * 16 + 2 * w + 1] = __expf(tot1); }
            __syncthreads();
            const f32x4 d4 = *(const f32x4*)(decl + buf * 16 + (l >> 4) * 4);
#pragma unroll
            for (int e = 0; e < 2; ++e) acc[e] = acc[e] * d4;
#pragma unroll
            for (int ks = 0; ks < 2; ++ks) {
                const bf16x8 af = *(const bf16x8*)(kdl + (buf * 16 + (l & 15)) * 64 + ks * 32 + (l >> 4) * 8);
#pragma unroll
                for (int e = 0; e < 2; ++e) acc[e] = MFMA16(af, vfr[e][ks], acc[e]);
            }
            const int cidx = b * 64 + n;
#pragma unroll
            for (int e = 0; e < 2; ++e) {
                const int vv = (2 * w + e) * 16 + (l & 15);
                *(u32x2*)(ST + (((size_t)(cidx * 4 + hh)) * 256 + vv) * 128 + ksl * 16 + (l >> 4) * 4) = pk4(acc[e].x, acc[e].y, acc[e].z, acc[e].w);
            }
        }
    }
}

DI void ph_gla_out(const Params& P, int j, int vb, int nb, int tid, int dry = 0) {
    (void)dry;
    LANE_DECODE
    const bf16_t* GQ = (const bf16_t*)(P.ws + OFF_GQ); const bf16_t* ST = (const bf16_t*)(P.ws + OFF_ST); const bf16_t* GR = (const bf16_t*)(P.ws + OFF_GR); bf16_t* OG = (bf16_t*)(P.ws + OFF_OG);
    const float* on = P.gla_o_norm + j * 1024;
    f32x2* red = (f32x2*)smem;
    for (int u = vb; u < 2048; u += nb) {
        const int cidx = u >> 2, hh = u & 3, tok0 = cidx * 64;
        bf16x8 bfr[8], afr[2][8];
#pragma unroll
        for (int ks = 0; ks < 8; ++ks) {
            bfr[ks] = *(const bf16x8*)(ST + (((size_t)(cidx * 4 + hh)) * 256 + 32 * w + li) * 128 + ks * 16 + h * 8);
#pragma unroll
            for (int mi = 0; mi < 2; ++mi) afr[mi][ks] = *(const bf16x8*)(GQ + (size_t)(tok0 + mi * 32 + li) * 512 + hh * 128 + ks * 16 + h * 8);
        }
        f32x4 gn[4]; u32x2 rr[2][4];
#pragma unroll
        for (int g = 0; g < 4; ++g) {
            const int v0 = hh * 256 + 32 * w + 8 * g + 4 * h;
            gn[g] = *(const f32x4*)(on + v0);
#pragma unroll
            for (int mi = 0; mi < 2; ++mi) rr[mi][g] = *(const u32x2*)(GR + (size_t)(tok0 + mi * 32 + li) * 1024 + v0);
        }
        f32x16 acc[2];
#pragma unroll
        for (int mi = 0; mi < 2; ++mi)
#pragma unroll
            for (int i = 0; i < 16; ++i) acc[mi][i] = 0.f;
#pragma unroll
        for (int ks = 0; ks < 8; ++ks)
#pragma unroll
            for (int mi = 0; mi < 2; ++mi) acc[mi] = MFMA32(bfr[ks], afr[mi][ks], acc[mi]);
#pragma unroll
        for (int mi = 0; mi < 2; ++mi) {
            float s1 = 0.f, s2 = 0.f;
#pragma unroll
            for (int i = 0; i < 16; ++i) { s1 += acc[mi][i]; s2 += acc[mi][i] * acc[mi][i]; }
            s1 += __shfl_xor(s1, 32); s2 += __shfl_xor(s2, 32);
            if (h == 0) red[w * 64 + mi * 32 + li] = (f32x2){s1, s2};
        }
        __syncthreads();
#pragma unroll
        for (int mi = 0; mi < 2; ++mi) {
            float s1 = 0.f, s2 = 0.f;
#pragma unroll
            for (int ww = 0; ww < 8; ++ww) { const f32x2 t = red[ww * 64 + mi * 32 + li]; s1 += t.x; s2 += t.y; }
            const float mean = s1 * (1.f / 256.f), var = fmaxf(s2 * (1.f / 256.f) - mean * mean, 0.f), rstd = __builtin_amdgcn_rsqf(var + EPS);
            const int tok = tok0 + mi * 32 + li;
#pragma unroll
            for (int g = 0; g < 4; ++g) {
                const int v0 = hh * 256 + 32 * w + 8 * g + 4 * h;
                const u32x2 r2 = rr[mi][g];
                const float o0 = (acc[mi][4 * g] - mean) * rstd * gn[g].x * bf2f(r2.x & 0xffffu), o1 = (acc[mi][4 * g + 1] - mean) * rstd * gn[g].y * bf2f(r2.x >> 16);
                const float o2 = (acc[mi][4 * g + 2] - mean) * rstd * gn[g].z * bf2f(r2.y & 0xffffu), o3 = (acc[mi][4 * g + 3] - mean) * rstd * gn[g].w * bf2f(r2.y >> 16);
                *(u32x2*)(OG + (size_t)tok * 1024 + v0) = pk4(o0, o1, o2, o3);
            }
        }
        __syncthreads();
    }
}

#define XB_TMO      128
#define XB_XCNT(j)  (256  + 64 * (j))
#define XB_XSUB(j)  (1280 + 64 * (j))
#define XB_XGEN(j)  (2304 + 64 * (j))
#define XB_TOP      3328
#define XB_TOPGEN   3392
#define XCD_BAR_WORDS 3456
#define XB_SPIN_CAP (1u << 20)
#define LAS __attribute__((address_space(3)))
DI unsigned xb_ld(unsigned* p)              { return __hip_atomic_load(p, __ATOMIC_RELAXED, __HIP_MEMORY_SCOPE_AGENT); }
DI unsigned xb_add(unsigned* p, unsigned v) { return __hip_atomic_fetch_add(p, v, __ATOMIC_RELAXED, __HIP_MEMORY_SCOPE_AGENT); }
DI unsigned xb_xcc_id() { return (unsigned)__builtin_amdgcn_s_getreg((3 << 11) | 20) & 0xFu; }
#define XB_SPIN(cond, bar) do { unsigned _sp = 0; while (cond) { __builtin_amdgcn_s_sleep(1); \
    if ((++_sp & 255u) == 0u) { if (xb_ld(&(bar)[XB_TMO])) break; if (_sp > XB_SPIN_CAP) { atomicAdd(&(bar)[XB_TMO], 1u); break; } } } } while (0)
struct XcdBarrier { unsigned* bar; unsigned x; volatile LAS unsigned* st; };
DI XcdBarrier xcd_barrier_post(unsigned* bar, volatile LAS unsigned* st) {
    XcdBarrier b; b.bar = bar; b.x = xb_xcc_id(); b.st = st;
    if (threadIdx.x == 0) (void)xb_add(&bar[XB_XCNT(b.x)], 1u);
    return b;
}
DI void xcd_barrier_complete(unsigned* bar, unsigned x, unsigned& nloc, unsigned& nx) {
    const unsigned G = gridDim.x * gridDim.y * gridDim.z;
    unsigned sum, cnt, mine, sp = 0u;
    for (;;) {
        sum = 0u; cnt = 0u; mine = 0u;
#pragma unroll
        for (unsigned j = 0; j < 16; ++j) { const unsigned c = xb_ld(&bar[XB_XCNT(j)]); sum += c; cnt += (c > 0u) ? 1u : 0u; mine = (j == x) ? c : mine; }
        if (sum == G) break;
        __builtin_amdgcn_s_sleep(1);
        if ((++sp & 255u) == 0u) { if (xb_ld(&bar[XB_TMO])) break; if (sp > XB_SPIN_CAP) { atomicAdd(&bar[XB_TMO], 1u); break; } }
    }
    nloc = mine > 0u ? mine : 1u; nx = cnt > 0u ? cnt : 1u;
}
DI void xcd_barrier(const XcdBarrier& b) {
    asm volatile("s_waitcnt vmcnt(0)" ::: "memory");
    __syncthreads();
    if (threadIdx.x == 0) {
        unsigned* bar = b.bar;
        __builtin_amdgcn_s_waitcnt(0);
        unsigned nloc = b.st[0], nx = b.st[1];
        if (nloc == 0u) { xcd_barrier_complete(bar, b.x, nloc, nx); b.st[0] = nloc; b.st[1] = nx; }
        const unsigned old = xb_add(&bar[XB_XSUB(b.x)], 1u);
        const unsigned gen = old / nloc;
        if (old + 1u == (gen + 1u) * nloc) {
            __builtin_amdgcn_fence(__ATOMIC_RELEASE, "agent");
            asm volatile("s_waitcnt vmcnt(0)" ::: "memory");
            const unsigned og = xb_add(&bar[XB_TOP], 1u);
            const unsigned tg = og / nx;
            if (og + 1u == (tg + 1u) * nx) xb_add(&bar[XB_TOPGEN], 1u);
            else XB_SPIN(xb_ld(&bar[XB_TOPGEN]) == tg, bar);
            __builtin_amdgcn_fence(__ATOMIC_ACQUIRE, "agent");
            xb_add(&bar[XB_XGEN(b.x)], 1u);
            asm volatile("s_waitcnt vmcnt(0)" ::: "memory");
        } else {
            XB_SPIN(xb_ld(&bar[XB_XGEN(b.x)]) == gen, bar);
            __builtin_amdgcn_fence(__ATOMIC_ACQUIRE, "agent");
            asm volatile("s_waitcnt vmcnt(0)" ::: "memory");
        }
    }
    __syncthreads();
}

__global__ void __launch_bounds__(NTH) mega(Params P) {
    cg::grid_group grid = cg::this_grid();
    const int tid0 = threadIdx.x, nb = gridDim.x, bid = blockIdx.x;
    const int vb0 = ((nb & 7) == 0) ? (bid & 7) * (nb >> 3) + (bid >> 3) : bid;
    int ph = 0;
    const int lo = P.ph_lo, hi = P.ph_hi;
    __shared__ uint4 xb_words;
    if (tid0 == 0) xb_words = make_uint4(0u, 0u, 0u, 0u);
    __syncthreads();
    const XcdBarrier xb = xcd_barrier_post((unsigned*)(P.ws + OFF_BAR), (volatile LAS unsigned*)&xb_words);
#define GSYNC() { if (ph == 0) grid.sync(); else xcd_barrier(xb); }
#define PHASE1(body) { int tid = tid0, vb = vb0; asm volatile("" : "+v"(tid)); asm volatile("" : "+s"(vb)); body; }
#define PHASE(cls, fn, ...) { if (ph >= lo && ph < hi) { if ((PROBE_MASK >> cls) & 1) { PHASE1(fn(__VA_ARGS__, P.dry)) xcd_barrier(xb); } PHASE1(fn(__VA_ARGS__)) if (ph + 1 < hi) GSYNC() } ++ph; }
    if ((PROBE_MASK >> 11) & 1) { for (int i = 0; i < 50; ++i) xcd_barrier(xb); }
    PHASE(0, prologue, P, vb, nb, tid)
    for (int L = 0; L < 4; ++L) {
        const int j = L >> 1;
        const float* g1 = P.ln1_g + L * 1024; const float* b1 = P.ln1_b + L * 1024; const float* g2 = P.ln2_g + L * 1024; const float* b2 = P.ln2_b + L * 1024;
        if ((L & 1) == 0) {
            PHASE(1, ph_mla_in, P, j, vb, nb, tid)
            for (int half = 0; half < 2; ++half) {
                PHASE(1, ph_mla_up, P, j, half, vb, nb, tid)
                PHASE(2, ph_attn, P, half, vb, nb, tid)
                PHASE(3, (ph_res<1, false>), P, (const bf16_t*)(P.ws + OFF_Q), 3072, 2048, (const bf16_t*)(P.ws + OFF_WB) + WB_MLA + j * W_MLA_SZ + W_MLA_O, half * HALF_T, HALF_T, g1, b1, (L == 0 ? P.x : (const float*)P.out), vb, nb, tid)
            }
        } else {
            PHASE(1, ph_gla_in, P, j, vb, nb, tid)
            PHASE(9, ph_gla_scan, P, j, vb, nb, tid)
            PHASE(10, ph_gla_out, P, j, vb, nb, tid)
            PHASE(3, (ph_res<0, false>), P, (const bf16_t*)(P.ws + OFF_OG), 1024, 1024, (const bf16_t*)(P.ws + OFF_WB) + WB_GLA + j * W_GLA_SZ + W_GLA_O, 0, TT, g1, b1, (const float*)P.out, vb, nb, tid)
        }
        PHASE(4, ln_phase, P.out, (bf16_t*)(P.ws + OFF_XB), (f32x2*)(P.ws + OFF_STATS), g1, b1, vb, nb, tid)
        PHASE(5, ph_ffn_up, P, L, vb, nb, tid)
        PHASE(6, (ph_res<0, true>), P, (const bf16_t*)(P.ws + OFF_GATED), DFF, DFF, (const bf16_t*)(P.ws + OFF_WB) + WB_FFN + L * W_FFN_SZ + W_FFN_DN, 0, TT, g1, b1, (const float*)P.out, vb, nb, tid)
        PHASE(4, ln_phase, P.out, (bf16_t*)(P.ws + OFF_XB), (f32x2*)(P.ws + OFF_STATS), g2, b2, vb, nb, tid)
        PHASE(7, ph_ple, P, L, g2, b2, vb, nb, tid)
    }
}
constexpr int NPHASES = 1 + 2 * (1 + 6 + 5) + 2 * (4 + 5);

extern "C" void kernel_launch(void* const* d_in, const int* in_sizes, int n_in, void* d_out, int out_size, void* d_ws, size_t ws_size, hipStream_t stream) {
    static int grid_blocks = 0;
    if (!grid_blocks) {
        int dev = 0, cus = 0, per_cu = 0;
        hipGetDevice(&dev);
        hipDeviceGetAttribute(&cus, hipDeviceAttributeMultiprocessorCount, dev);
        hipFuncSetAttribute((const void*)mega, hipFuncAttributeMaxDynamicSharedMemorySize, LDS_BYTES);
        hipOccupancyMaxActiveBlocksPerMultiprocessor(&per_cu, (const void*)mega, NTH, LDS_BYTES);
        if (per_cu < 1) per_cu = 1;
        grid_blocks = cus * per_cu;
        if (grid_blocks > 256) grid_blocks = 256;
        if (ws_size < WS_NEED) fprintf(stderr, "kernel_launch: workspace too small: %zu < %zu\n", ws_size, (size_t)WS_NEED);
    }
    Params P{};
    P.x = (const float*)d_in[0]; P.p = (const float*)d_in[1]; P.pos = (const int*)d_in[2];
    P.mla_w_in = (const float*)d_in[3]; P.mla_q_norm = (const float*)d_in[4]; P.mla_kv_norm = (const float*)d_in[5]; P.mla_w_uq = (const float*)d_in[6];
    P.mla_w_uk = (const float*)d_in[7]; P.mla_w_uv = (const float*)d_in[8]; P.mla_w_o = (const float*)d_in[9];
    P.gla_w_in = (const float*)d_in[10]; P.gla_w_a2 = (const float*)d_in[11]; P.gla_b_a = (const float*)d_in[12]; P.gla_o_norm = (const float*)d_in[13]; P.gla_w_o = (const float*)d_in[14];
    P.ln1_g = (const float*)d_in[15]; P.ln1_b = (const float*)d_in[16]; P.ln2_g = (const float*)d_in[17]; P.ln2_b = (const float*)d_in[18];
    P.ffn_w_up = (const float*)d_in[19]; P.ffn_conv_w = (const float*)d_in[20]; P.ffn_conv_b = (const float*)d_in[21]; P.ffn_w_down = (const float*)d_in[22];
    P.ple_w_proj = (const float*)d_in[23]; P.ple_w_gate = (const float*)d_in[24]; P.ple_b_gate = (const float*)d_in[25];
    P.out = (float*)d_out; P.ws = (char*)d_ws;
    for (int i = 0; i < 32; ++i) P.invrev[i] = (1.0 / pow(10000.0, (double)(2 * i) / 64.0)) / (2.0 * M_PI);
#if MULTI_LAUNCH
    for (int ph = 0; ph < NPHASES; ++ph) {
        P.ph_lo = ph; P.ph_hi = ph + 1; P.dry = 1;
        hipLaunchKernelGGL(mega, dim3(grid_blocks), dim3(NTH), LDS_BYTES, stream, P);
    }
#else
    P.ph_lo = 0; P.ph_hi = NPHASES; P.dry = 1;
    (void)hipMemsetAsync((char*)d_ws + OFF_BAR, 0, 16384, stream);
    void* args[] = {&P};
    hipError_t e = hipLaunchCooperativeKernel((const void*)mega, dim3(grid_blocks), dim3(NTH), args, LDS_BYTES, stream);
    if (e != hipSuccess) fprintf(stderr, "cooperative launch failed: %s (grid %d)\n", hipGetErrorString(e), grid_blocks);
#endif
}
```

```cpp
#include <hip/hip_runtime.h>
#include <hip/hip_cooperative_groups.h>
#include <cstdio>
#include <cmath>
#include <type_traits>
namespace cg = cooperative_groups;

#ifndef MULTI_LAUNCH
#define MULTI_LAUNCH 0
#endif
#ifndef PROBE_MASK
#define PROBE_MASK 0
#endif

#define DI __device__ __forceinline__
typedef unsigned short bf16_t;
typedef short bf16x8 __attribute__((ext_vector_type(8)));
typedef float f32x16 __attribute__((ext_vector_type(16)));
typedef float f32x4 __attribute__((ext_vector_type(4)));
typedef float f32x2 __attribute__((ext_vector_type(2)));
typedef unsigned u32x4 __attribute__((ext_vector_type(4)));
typedef unsigned u32x2 __attribute__((ext_vector_type(2)));
typedef int i32x4 __attribute__((ext_vector_type(4)));
typedef __bf16 bf16x2_t __attribute__((ext_vector_type(2)));

#define MFMA32(a, b, c) __builtin_amdgcn_mfma_f32_32x32x16_bf16((a), (b), (c), 0, 0, 0)
#define MFMA16(a, b, c) __builtin_amdgcn_mfma_f32_16x16x32_bf16((a), (b), (c), 0, 0, 0)

DI unsigned pk2(float lo, float hi) { f32x2 v = {lo, hi}; return __builtin_bit_cast(unsigned, __builtin_convertvector(v, bf16x2_t)); }
DI bf16_t f2bf(float x) { return (bf16_t)(pk2(x, 0.f) & 0xffffu); }
DI float bf2f(unsigned x) { return __uint_as_float(x << 16); }
DI u32x2 pk4(float a, float b, float c, float d) { u32x2 r; r.x = pk2(a, b); r.y = pk2(c, d); return r; }
DI float fexp2(float x) { return __builtin_amdgcn_exp2f(x); }
DI float frcp(float x) { return __builtin_amdgcn_rcpf(x); }
DI float sigmoidf_(float x) { return frcp(1.f + fexp2(-1.44269504089f * x)); }
DI float gelu_tanh(float x) { const float t = __builtin_fmaf(x * x, -0.10294324f, -2.30220820f); return x * frcp(1.f + fexp2(t * x)); }

constexpr int TT = 32768, SS = 4096, DM = 1024;
constexpr int NTH = 512;
constexpr float DN_ALPHA = 1.6817928305074292f;
constexpr float EPS = 1e-5f;
constexpr int DFF = 2816;
constexpr int HALF_T = TT / 2;

constexpr size_t MiB = 1u << 20;
constexpr size_t OFF_WB = 0;
constexpr size_t OFF_COS = 116 * MiB, OFF_SIN = 120 * MiB, OFF_SSQ = 124 * MiB, OFF_KROPE = 126 * MiB, OFF_GA = 130 * MiB;
constexpr size_t OFF_CID = 132 * MiB, OFF_TMIN = OFF_CID + 256 * 1024, OFF_TMAX = OFF_TMIN + 4096;
constexpr size_t OFF_STATS = 133 * MiB;
constexpr size_t OFF_BAR = 134 * MiB;
constexpr size_t OFF_XB = 136 * MiB;
constexpr size_t OFF_H = 200 * MiB, OFF_Q = 248 * MiB, OFF_KN = 344 * MiB, OFF_VT = 408 * MiB;
constexpr size_t OFF_ST = 136 * MiB, OFF_GQ = 264 * MiB, OFF_GK = 296 * MiB, OFF_GVT = 328 * MiB, OFF_OG = 328 * MiB, OFF_GR = 392 * MiB;
constexpr size_t OFF_GATED = 200 * MiB;
constexpr size_t OFF_XBN_A = 200 * MiB, OFF_XBN_B = 392 * MiB;
constexpr size_t WS_NEED = 472 * MiB;

constexpr size_t W_MLA_IN = 0, W_MLA_UQ = W_MLA_IN + 896 * 1024, W_MLA_KV = W_MLA_UQ + 3072 * 512, W_MLA_O = W_MLA_KV + 4096 * 256, W_MLA_SZ = W_MLA_O + 1024 * 2048;
constexpr size_t W_GLA_IN = 0, W_GLA_O = W_GLA_IN + 3328 * 1024, W_GLA_SZ = W_GLA_O + 1024 * 1024;
constexpr size_t W_FFN_UP = 0, W_FFN_DN = W_FFN_UP + 5632 * 1024, W_FFN_SZ = W_FFN_DN + 1024 * 2816;
constexpr size_t W_PLE_G = 0, W_PLE_P = W_PLE_G + 1024 * 1024, W_PLE_SZ = W_PLE_P + 1024 * 256;
constexpr size_t WB_MLA = 0, WB_GLA = WB_MLA + 2 * W_MLA_SZ, WB_FFN = WB_GLA + 2 * W_GLA_SZ, WB_PLE = WB_FFN + 4 * W_FFN_SZ, WB_END = WB_PLE + 4 * W_PLE_SZ;
static_assert(WB_END * 2 <= 116 * MiB, "weight arena");

constexpr int G_STAGE = 49152, G_BOFF = 32768, XCH_OFF = 3 * G_STAGE, LDS_BYTES = XCH_OFF + 4096;
constexpr int AT_KB = 24576, AT_STAGE = 40960;

struct Params {
    const float* x; const float* p; const int* pos;
    const float *mla_w_in, *mla_q_norm, *mla_kv_norm, *mla_w_uq, *mla_w_uk, *mla_w_uv, *mla_w_o;
    const float *gla_w_in, *gla_w_a2, *gla_b_a, *gla_o_norm, *gla_w_o;
    const float *ln1_g, *ln1_b, *ln2_g, *ln2_b;
    const float *ffn_w_up, *ffn_conv_w, *ffn_conv_b, *ffn_w_down;
    const float *ple_w_proj, *ple_w_gate, *ple_b_gate;
    float* out; char* ws;
    double invrev[32];
    int ph_lo, ph_hi, dry, pad_;
};

extern __shared__ __attribute__((aligned(16))) char smem[];

template <bool AF32> struct AReg { u32x4 v[AF32 ? 8 : 4]; };
#define RAW_BARRIER() do { asm volatile("s_waitcnt lgkmcnt(0)" ::: "memory"); __builtin_amdgcn_s_barrier(); } while (0)

template <bool AF32, int AMODE, bool SWAP>
DI void mainloop_rs(f32x16 (&acc)[2][2], const void* Abase, int lda, int arow0, int amax, const bf16_t* Bbase, int ldb, int brow0, int nk, int tid) {
    const int l = tid & 63, w = tid >> 6, wr = w >> 1, wc = w & 1, h = l >> 5, li = l & 31;
    const int lc = tid & 7, lr = tid >> 3;
    const int st_off = lr * 128 + ((lc ^ ((lr >> 1) & 7)) << 4);
    const int lk = h ^ ((l >> 1) & 7);
    const int a_off = (wr * 64 + li) * 128, b_off = G_BOFF + (wc * 64 + li) * 128;
#pragma unroll
    for (int mi = 0; mi < 2; ++mi)
#pragma unroll
        for (int ni = 0; ni < 2; ++ni)
#pragma unroll
            for (int r = 0; r < 16; ++r) acc[mi][ni][r] = 0.f;
    AReg<AF32> ra; u32x4 rb[2];
    long arow[4];
#pragma unroll
    for (int i = 0; i < 4; ++i) { int row = arow0 + lr + 64 * i; row = row < 0 ? 0 : (row > amax ? amax : row); arow[i] = (long)row * lda + lc * 8; }
    const bf16_t* bp = Bbase + (long)(brow0 + lr) * ldb + lc * 8;
    auto gload = [&](int kt) {
        const int ka = (AMODE == 1) ? ((kt >> 1) * 192 + (kt & 1) * 64) : kt * 64;
#pragma unroll
        for (int i = 0; i < 4; ++i) {
            if (!AF32) ra.v[i] = *(const u32x4*)((const bf16_t*)Abase + arow[i] + ka);
            else { const float* p = (const float*)Abase + arow[i] + ka; ra.v[2 * i] = *(const u32x4*)p; ra.v[2 * i + 1] = *(const u32x4*)(p + 4); }
        }
#pragma unroll
        for (int i = 0; i < 2; ++i) rb[i] = *(const u32x4*)(bp + (long)(64 * i) * ldb + kt * 64);
    };
    auto lstore = [&](int s) {
        char* sb = smem + s * G_STAGE;
#pragma unroll
        for (int i = 0; i < 4; ++i) {
            u32x4 v;
            if (!AF32) v = ra.v[i];
            else { const u32x4 a = ra.v[2 * i], b = ra.v[2 * i + 1];
                v.x = pk2(__uint_as_float(a.x), __uint_as_float(a.y)); v.y = pk2(__uint_as_float(a.z), __uint_as_float(a.w));
                v.z = pk2(__uint_as_float(b.x), __uint_as_float(b.y)); v.w = pk2(__uint_as_float(b.z), __uint_as_float(b.w)); }
            *(u32x4*)(sb + st_off + i * 8192) = v;
        }
#pragma unroll
        for (int i = 0; i < 2; ++i) *(u32x4*)(sb + G_BOFF + st_off + i * 8192) = rb[i];
    };
    __syncthreads();
    gload(0); lstore(0); __syncthreads();
    for (int kt = 0; kt < nk; ++kt) {
        const bool more = kt + 1 < nk;
        if (more) gload(kt + 1);
        const char* sb = smem + (kt & 1) * G_STAGE;
#pragma unroll
        for (int ks = 0; ks < 4; ++ks) {
            const int co = (lk ^ (2 * ks)) << 4;
            bf16x8 a0 = *(const bf16x8*)(sb + a_off + co), a1 = *(const bf16x8*)(sb + a_off + 4096 + co);
            bf16x8 b0 = *(const bf16x8*)(sb + b_off + co), b1 = *(const bf16x8*)(sb + b_off + 4096 + co);
            if (!SWAP) { acc[0][0] = MFMA32(a0, b0, acc[0][0]); acc[0][1] = MFMA32(a0, b1, acc[0][1]); acc[1][0] = MFMA32(a1, b0, acc[1][0]); acc[1][1] = MFMA32(a1, b1, acc[1][1]); }
            else { acc[0][0] = MFMA32(b0, a0, acc[0][0]); acc[0][1] = MFMA32(b1, a0, acc[0][1]); acc[1][0] = MFMA32(b0, a1, acc[1][0]); acc[1][1] = MFMA32(b1, a1, acc[1][1]); }
        }
        if (more) lstore((kt + 1) & 1);
        __syncthreads();
    }
}

template <int MI> struct Cfg { static constexpr int NWC = (MI == 2 ? 2 : 4), BN = 64 * NWC, WROWS = 32 * MI, STAGE = (256 + BN) * 128, NBI = BN / 64; };
struct TD { const bf16_t* A; const bf16_t* B; int lda, ldb, arow0, amax, brow0, nk; };
DI TD mk_td(const bf16_t* A, int lda, int arow0, int amax, const bf16_t* B, int ldb, int brow0, int nk) { TD t; t.A = A; t.B = B; t.lda = lda; t.ldb = ldb; t.arow0 = arow0; t.amax = amax; t.brow0 = brow0; t.nk = nk; return t; }

template <int AMODE, bool SWAP, int MI>
DI void mainloop_dma(f32x16 (&acc)[MI][2], const TD& c, const TD& n, bool hasn, bool primed, int& s, int tid) {
    typedef Cfg<MI> C;
    const int l = tid & 63, w = tid >> 6, wr = w / C::NWC, wc = w % C::NWC, h = l >> 5, li = l & 31;
    const int lk = h ^ ((l >> 1) & 7);
    const int a_off = (wr * C::WROWS + li) * 128, b_off = G_BOFF + (wc * 64 + li) * 128;
    constexpr int NST = (MI == 2 ? 3 : 2);
#pragma unroll
    for (int mi = 0; mi < MI; ++mi)
#pragma unroll
        for (int ni = 0; ni < 2; ++ni)
#pragma unroll
            for (int r = 0; r < 16; ++r) acc[mi][ni][r] = 0.f;
    constexpr int NP = 4 + C::NBI;
    auto offs = [&](const TD& t, int (&ao)[4], int (&bo)[C::NBI]) {
#pragma unroll
        for (int i = 0; i < 4; ++i) {
            int row = t.arow0 + (4 * w + i) * 8 + (l >> 3); row = row < 0 ? 0 : (row > t.amax ? t.amax : row);
            ao[i] = row * t.lda + ((l & 7) ^ (((l >> 4) + 4 * (i & 1)) & 7)) * 8;
        }
#pragma unroll
        for (int i = 0; i < C::NBI; ++i) {
            const int row = t.brow0 + (C::NBI * w + i) * 8 + (l >> 3);
            bo[i] = row * t.ldb + ((l & 7) ^ (((l >> 4) + 4 * (i & 1)) & 7)) * 8;
        }
    };
    auto piece = [&](const TD& t, const int (&ao)[4], const int (&bo)[C::NBI], int kt, int st, int i) {
        char* sb = smem + st * C::STAGE;
        if (i < 4) {
            const int ka = (AMODE == 1) ? ((kt >> 1) * 192 + (kt & 1) * 64) : kt * 64;
            __builtin_amdgcn_global_load_lds((const __attribute__((address_space(1))) void*)(t.A + ka + ao[i]), (__attribute__((address_space(3))) void*)(sb + (4 * w + i) * 1024), 16, 0, 0);
        } else {
            __builtin_amdgcn_global_load_lds((const __attribute__((address_space(1))) void*)(t.B + kt * 64 + bo[i - 4]), (__attribute__((address_space(3))) void*)(sb + G_BOFF + (C::NBI * w + i - 4) * 1024), 16, 0, 0);
        }
    };
    int ao[4], bo[C::NBI];
    offs(c, ao, bo);
    const int nk = c.nk;
    if (!primed) {
        RAW_BARRIER();
        s = 0;
#pragma unroll
        for (int i = 0; i < NP; ++i) piece(c, ao, bo, 0, 0, i);
        if (MI == 2 && nk > 1) {
#pragma unroll
            for (int i = 0; i < NP; ++i) piece(c, ao, bo, 1, 1, i);
        }
    }
#pragma unroll 1
    for (int kt = 0; kt < nk; ++kt) {
        int ns, nkt;
        if (MI == 2) {
            if (kt + 1 < nk && kt > 0) asm volatile("s_waitcnt vmcnt(6)" ::: "memory"); else asm volatile("s_waitcnt vmcnt(0)" ::: "memory");
            RAW_BARRIER();
            ns = s >= 1 ? s - 1 : 2; nkt = kt + 2;
        } else {
            asm volatile("s_waitcnt vmcnt(0)" ::: "memory");
            RAW_BARRIER();
            ns = s ^ 1; nkt = kt + 1;
        }
        const bool doload = nkt < nk;
        const char* sb = smem + s * C::STAGE;
#pragma unroll
        for (int ks = 0; ks < 4; ++ks) {
            const int co = (lk ^ (2 * ks)) << 4;
            bf16x8 fa[MI], fb[2];
#pragma unroll
            for (int mi = 0; mi < MI; ++mi) fa[mi] = *(const bf16x8*)(sb + a_off + mi * 4096 + co);
            fb[0] = *(const bf16x8*)(sb + b_off + co); fb[1] = *(const bf16x8*)(sb + b_off + 4096 + co);
            asm volatile("" ::: "memory");
            if (doload) {
                constexpr int P0[5] = {0, (NP + 3) / 4, (NP + 3) / 4 + (NP + 2) / 4, (NP + 3) / 4 + (NP + 2) / 4 + (NP + 1) / 4, NP};
#pragma unroll
                for (int i = P0[ks]; i < P0[ks + 1]; ++i) piece(c, ao, bo, nkt, ns, i);
            }
            asm volatile("" ::: "memory");
#pragma unroll
            for (int mi = 0; mi < MI; ++mi)
#pragma unroll
                for (int ni = 0; ni < 2; ++ni) {
                    if (!SWAP) acc[mi][ni] = MFMA32(fa[mi], fb[ni], acc[mi][ni]);
                    else acc[mi][ni] = MFMA32(fb[ni], fa[mi], acc[mi][ni]);
                }
        }
        s = (s + 1 == NST) ? 0 : s + 1;
    }
    if (hasn) {
        offs(n, ao, bo);
#pragma unroll
        for (int i = 0; i < NP; ++i) piece(n, ao, bo, 0, s, i);
        if (MI == 2 && n.nk > 1) {
            const int s1 = (s + 1 == NST) ? 0 : s + 1;
#pragma unroll
            for (int i = 0; i < NP; ++i) piece(n, ao, bo, 1, s1, i);
        }
    }
}

template <int AMODE, bool SWAPO = true>
DI void mainloop_dma16(f32x4 (&acc)[4][2][2][2], const TD& c, const TD& n, bool hasn, bool primed, int& s, int tid) {
    constexpr int MI = 4; typedef Cfg<MI> C;
    const int l = tid & 63, w = tid >> 6, wr = w / C::NWC, wc = w % C::NWC, r16 = l & 15, q = l >> 4;
    const int key = (l >> 1) & 7;
    const int a_off = (wr * C::WROWS + r16) * 128, b_off = G_BOFF + (wc * 64 + r16) * 128;
#pragma unroll
    for (int mi = 0; mi < MI; ++mi)
#pragma unroll
        for (int ni = 0; ni < 2; ++ni)
#pragma unroll
            for (int rh = 0; rh < 2; ++rh)
#pragma unroll
                for (int ch = 0; ch < 2; ++ch) acc[mi][ni][rh][ch] = (f32x4){0.f, 0.f, 0.f, 0.f};
    constexpr int NP = 4 + C::NBI;
    auto offs = [&](const TD& t, int (&ao)[4], int (&bo)[C::NBI]) {
#pragma unroll
        for (int i = 0; i < 4; ++i) {
            int row = t.arow0 + (4 * w + i) * 8 + (l >> 3); row = row < 0 ? 0 : (row > t.amax ? t.amax : row);
            ao[i] = row * t.lda + ((l & 7) ^ (((l >> 4) + 4 * (i & 1)) & 7)) * 8;
        }
#pragma unroll
        for (int i = 0; i < C::NBI; ++i) {
            const int row = t.brow0 + (C::NBI * w + i) * 8 + (l >> 3);
            bo[i] = row * t.ldb + ((l & 7) ^ (((l >> 4) + 4 * (i & 1)) & 7)) * 8;
        }
    };
    auto piece = [&](const TD& t, const int (&ao)[4], const int (&bo)[C::NBI], int kt, int st, int i) {
        char* sb = smem + st * C::STAGE;
        if (i < 4) {
            const int ka = (AMODE == 1) ? ((kt >> 1) * 192 + (kt & 1) * 64) : kt * 64;
            __builtin_amdgcn_global_load_lds((const __attribute__((address_space(1))) void*)(t.A + ka + ao[i]), (__attribute__((address_space(3))) void*)(sb + (4 * w + i) * 1024), 16, 0, 0);
        } else {
            __builtin_amdgcn_global_load_lds((const __attribute__((address_space(1))) void*)(t.B + kt * 64 + bo[i - 4]), (__attribute__((address_space(3))) void*)(sb + G_BOFF + (C::NBI * w + i - 4) * 1024), 16, 0, 0);
        }
    };
    int ao[4], bo[C::NBI];
    offs(c, ao, bo);
    const int nk = c.nk;
    if (!primed) {
        RAW_BARRIER();
        s = 0;
#pragma unroll
        for (int i = 0; i < NP; ++i) piece(c, ao, bo, 0, 0, i);
    }
#pragma unroll 1
    for (int kt = 0; kt < nk; ++kt) {
        asm volatile("s_waitcnt vmcnt(0)" ::: "memory");
        RAW_BARRIER();
        const int ns = s ^ 1, nkt = kt + 1;
        const bool doload = nkt < nk;
        const char* sb = smem + s * C::STAGE;
#pragma unroll
        for (int k2 = 0; k2 < 2; ++k2) {
            const int co = ((4 * k2 + q) ^ key) << 4;
            bf16x8 fw[2][2];
#pragma unroll
            for (int ni = 0; ni < 2; ++ni)
#pragma unroll
                for (int rh = 0; rh < 2; ++rh) fw[ni][rh] = *(const bf16x8*)(sb + b_off + (ni * 32 + rh * 16) * 128 + co);
#pragma unroll
            for (int mh = 0; mh < 2; ++mh) {
                bf16x8 fx[2][2];
#pragma unroll
                for (int m2 = 0; m2 < 2; ++m2)
#pragma unroll
                    for (int ch = 0; ch < 2; ++ch) fx[m2][ch] = *(const bf16x8*)(sb + a_off + ((2 * mh + m2) * 32 + ch * 16) * 128 + co);
                asm volatile("" ::: "memory");
                if (doload) { const int p0 = (2 * k2 + mh) * 2; piece(c, ao, bo, nkt, ns, p0); piece(c, ao, bo, nkt, ns, p0 + 1); }
                asm volatile("" ::: "memory");
#pragma unroll
                for (int m2 = 0; m2 < 2; ++m2)
#pragma unroll
                    for (int ni = 0; ni < 2; ++ni)
#pragma unroll
                        for (int rh = 0; rh < 2; ++rh)
#pragma unroll
                            for (int ch = 0; ch < 2; ++ch)
                                acc[2 * mh + m2][ni][rh][ch] = SWAPO ? MFMA16(fw[ni][rh], fx[m2][ch], acc[2 * mh + m2][ni][rh][ch]) : MFMA16(fx[m2][ch], fw[ni][rh], acc[2 * mh + m2][ni][rh][ch]);
            }
        }
        s ^= 1;
    }
    if (hasn) {
        offs(n, ao, bo);
#pragma unroll
        for (int i = 0; i < NP; ++i) piece(n, ao, bo, 0, s, i);
    }
}

template <bool AF32, int AMODE, bool SWAP>
DI void mainloop(f32x16 (&acc)[2][2], const void* Abase, int lda, int arow0, int amax, const bf16_t* Bbase, int ldb, int brow0, int nk, int tid) {
    if constexpr (AF32) mainloop_rs<AF32, AMODE, SWAP>(acc, Abase, lda, arow0, amax, Bbase, ldb, brow0, nk, tid);
    else { int st = 0; const TD c = mk_td((const bf16_t*)Abase, lda, arow0, amax, Bbase, ldb, brow0, nk); mainloop_dma<AMODE, SWAP, 2>(acc, c, c, false, false, st, tid); }
}

DI void convT(const float* __restrict__ src, int K, int N, bf16_t* __restrict__ dst, int Npad, int mode, const float* __restrict__ gain, int vb, int nb, int& base, int tid) {
    float* tile = (float*)smem;
    const int nkt = K >> 6, ntiles = nkt * (Npad >> 6);
    int t0 = (vb - (base % nb) + nb) % nb;
    for (int t = t0; t < ntiles; t += nb) {
        const int kt = t % nkt, ntile = t / nkt, k0 = kt * 64, n0 = ntile * 64;
#pragma unroll
        for (int i = 0; i < 8; ++i) {
            const int k = (tid >> 6) + 8 * i, n = tid & 63, gn = n0 + n;
            float v = 0.f;
            if (gn < N) { v = src[(long)(k0 + k) * N + gn]; if (gain) v *= gain[k0 + k]; }
            tile[k * 65 + n] = v;
        }
        __syncthreads();
#pragma unroll
        for (int i = 0; i < 8; ++i) {
            const int n = (tid >> 6) + 8 * i, k = tid & 63, gn = n0 + n;
            int row = gn;
            if (mode == 1) { const int sub = gn >= DFF ? 1 : 0, c = gn - sub * DFF; row = (c >> 5) * 64 + sub * 32 + (c & 31); }
            dst[(long)row * K + k0 + k] = f2bf(tile[k * 65 + n]);
        }
        __syncthreads();
    }
    base += ntiles;
}

DI float wave_sum(float v) {
#pragma unroll
    for (int o = 32; o >= 1; o >>= 1) v += __shfl_xor(v, o);
    return v;
}

DI void prologue(const Params& P, int vb, int nb, int tid, int dry = 0) {
    (void)dry;
    bf16_t* WB = (bf16_t*)(P.ws + OFF_WB);
    int base = 0;
    for (int j = 0; j < 2; ++j) {
        bf16_t* wm = WB + WB_MLA + j * W_MLA_SZ;
        convT(P.mla_w_in + (size_t)j * 1024 * 832, 1024, 832, wm + W_MLA_IN, 896, 0, nullptr, vb, nb, base, tid);
        convT(P.mla_w_uq + (size_t)j * 512 * 3072, 512, 3072, wm + W_MLA_UQ, 3072, 0, P.mla_q_norm + j * 512, vb, nb, base, tid);
        convT(P.mla_w_uk + (size_t)j * 256 * 2048, 256, 2048, wm + W_MLA_KV, 2048, 0, P.mla_kv_norm + j * 256, vb, nb, base, tid);
        convT(P.mla_w_uv + (size_t)j * 256 * 2048, 256, 2048, wm + W_MLA_KV + 2048 * 256, 2048, 0, P.mla_kv_norm + j * 256, vb, nb, base, tid);
        convT(P.mla_w_o + (size_t)j * 2048 * 1024, 2048, 1024, wm + W_MLA_O, 1024, 0, nullptr, vb, nb, base, tid);
        bf16_t* wg = WB + WB_GLA + j * W_GLA_SZ;
        convT(P.gla_w_in + (size_t)j * 1024 * 3088, 1024, 3088, wg + W_GLA_IN, 3328, 0, nullptr, vb, nb, base, tid);
        convT(P.gla_w_o + (size_t)j * 1024 * 1024, 1024, 1024, wg + W_GLA_O, 1024, 0, nullptr, vb, nb, base, tid);
    }
    for (int i = 0; i < 4; ++i) {
        bf16_t* wf = WB + WB_FFN + i * W_FFN_SZ;
        convT(P.ffn_w_up + (size_t)i * 1024 * 5632, 1024, 5632, wf + W_FFN_UP, 5632, 1, nullptr, vb, nb, base, tid);
        convT(P.ffn_w_down + (size_t)i * 2816 * 1024, 2816, 1024, wf + W_FFN_DN, 1024, 0, nullptr, vb, nb, base, tid);
        bf16_t* wp = WB + WB_PLE + i * W_PLE_SZ;
        convT(P.ple_w_gate + (size_t)i * 1024 * 1024, 1024, 1024, wp + W_PLE_G, 1024, 0, nullptr, vb, nb, base, tid);
        convT(P.ple_w_proj + (size_t)i * 256 * 1024, 256, 1024, wp + W_PLE_P, 1024, 0, nullptr, vb, nb, base, tid);
    }
    {
        const f32x4* xs = (const f32x4*)P.x; f32x4* xo = (f32x4*)P.out; u32x2* xb = (u32x2*)(P.ws + OFF_XB);
        const int n4 = TT * DM / 4;
        for (int i = vb * NTH + tid; i < n4; i += nb * NTH) { f32x4 v = xs[i]; xb[i] = pk4(v.x, v.y, v.z, v.w); }
        (void)xo;
    }
    {
        float* COS = (float*)(P.ws + OFF_COS); float* SIN = (float*)(P.ws + OFF_SIN);
        for (int i = vb * NTH + tid; i < TT * 32; i += nb * NTH) {
            const int t = i >> 5, f = i & 31;
            double rev = (double)P.pos[t] * P.invrev[f];
            rev -= rint(rev);
            const float fr = (float)rev;
            COS[i] = __builtin_amdgcn_cosf(fr); SIN[i] = __builtin_amdgcn_sinf(fr);
        }
    }
    {
        int* CID = (int*)(P.ws + OFF_CID); int* TMIN = (int*)(P.ws + OFF_TMIN); int* TMAX = (int*)(P.ws + OFF_TMAX);
        const int l = tid & 63, w = tid >> 6;
        for (int tl = vb * 8 + w; tl < TT / 64; tl += nb * 8) {
            const int c = P.pos[tl * 64 + l] >> 6;
            CID[tl * 64 + l] = c;
            int mn = c, mx = c;
#pragma unroll
            for (int o = 32; o >= 1; o >>= 1) { mn = min(mn, __shfl_xor(mn, o)); mx = max(mx, __shfl_xor(mx, o)); }
            if (l == 0) { TMIN[tl] = mn; TMAX[tl] = mx; }
        }
    }
}

DI void ln_phase(const float* X32, bf16_t* Xb, f32x2* STATS, const float* __restrict__ g, const float* __restrict__ b, int vb, int nb, int tid, int dry = 0) {
    const int l = tid & 63, w = tid >> 6;
    f32x4 gg[4], bb[4];
#pragma unroll
    for (int j = 0; j < 4; ++j) { gg[j] = ((const f32x4*)g)[l + 64 * j]; bb[j] = ((const f32x4*)b)[l + 64 * j]; }
    const int stride = nb * 8;
    for (int row = vb * 8 + w; row < TT; row += 2 * stride) {
        const int row2 = row + stride; const bool has2 = row2 < TT;
        const f32x4* xr = (const f32x4*)(X32 + (size_t)row * DM); const f32x4* xr2 = (const f32x4*)(X32 + (size_t)(has2 ? row2 : row) * DM);
        f32x4 v[4], u[4]; float s = 0.f, t = 0.f;
#pragma unroll
        for (int j = 0; j < 4; ++j) { v[j] = xr[l + 64 * j]; u[j] = xr2[l + 64 * j]; }
#pragma unroll
        for (int j = 0; j < 4; ++j) { s += (v[j].x + v[j].y) + (v[j].z + v[j].w); t += (u[j].x + u[j].y) + (u[j].z + u[j].w); }
        const float mean = wave_sum(s) * (1.f / DM), mean2 = wave_sum(t) * (1.f / DM); float s2 = 0.f, t2 = 0.f;
#pragma unroll
        for (int j = 0; j < 4; ++j) { v[j] = v[j] - mean; u[j] = u[j] - mean2; s2 += (v[j].x * v[j].x + v[j].y * v[j].y) + (v[j].z * v[j].z + v[j].w * v[j].w); t2 += (u[j].x * u[j].x + u[j].y * u[j].y) + (u[j].z * u[j].z + u[j].w * u[j].w); }
        const float rstd = __builtin_amdgcn_rsqf(wave_sum(s2) * (1.f / DM) + EPS), rstd2 = __builtin_amdgcn_rsqf(wave_sum(t2) * (1.f / DM) + EPS);
        if (!dry) {
            u32x2* xb = (u32x2*)(Xb + (size_t)row * DM);
            if (l == 0) STATS[row] = (f32x2){mean, rstd};
#pragma unroll
            for (int j = 0; j < 4; ++j) { f32x4 o = v[j] * rstd * gg[j] + bb[j]; xb[l + 64 * j] = pk4(o.x, o.y, o.z, o.w); }
            if (has2) {
                u32x2* xb2 = (u32x2*)(Xb + (size_t)row2 * DM);
                if (l == 0) STATS[row2] = (f32x2){mean2, rstd2};
#pragma unroll
                for (int j = 0; j < 4; ++j) { f32x4 o = u[j] * rstd2 * gg[j] + bb[j]; xb2[l + 64 * j] = pk4(o.x, o.y, o.z, o.w); }
            }
        }
    }
}

#define LAUNDER_TID int tid_e = tid; asm volatile("" : "+v"(tid_e));
#define LANE_DECODE_E(MI_) const int l = tid_e & 63, w = tid_e >> 6, wr = w / Cfg<MI_>::NWC, wc = w % Cfg<MI_>::NWC, h = l >> 5, li = l & 31; (void)l; (void)w; (void)wr; (void)wc; (void)h; (void)li;
#define LANE_DECODE_T(MI_) const int l = tid & 63, w = tid >> 6, wr = w / Cfg<MI_>::NWC, wc = w % Cfg<MI_>::NWC, h = l >> 5, li = l & 31; (void)l; (void)w; (void)wr; (void)wc; (void)h; (void)li;
#define LANE_DECODE const int l = tid & 63, w = tid >> 6, wr = w >> 1, wc = w & 1, h = l >> 5, li = l & 31; (void)l; (void)w; (void)wr; (void)wc; (void)h; (void)li;

template <class F>
DI void wave_rows_store(char* buf, int l, bf16_t* grow0, size_t ld, F vals) {
    const int li = l & 31, h = l >> 5;
#pragma unroll
    for (int ni = 0; ni < 2; ++ni)
#pragma unroll
        for (int g = 0; g < 4; ++g) *(u32x2*)(buf + li * 144 + ni * 64 + g * 16 + h * 8) = vals(ni, g);
#pragma unroll
    for (int jj = 0; jj < 4; ++jj) {
        const int row = (l >> 3) + 8 * jj;
        const u32x4 v = *(const u32x4*)(buf + row * 144 + (l & 7) * 16);
        *(u32x4*)(grow0 + (size_t)row * ld + (l & 7) * 8) = v;
    }
}

template <class F>
DI void wave_rows_store16(char* buf, int l, bf16_t* grow0, size_t ld, F vals) {
    const int r16 = l & 15, q = l >> 4;
#pragma unroll
    for (int ni = 0; ni < 2; ++ni)
#pragma unroll
        for (int rh = 0; rh < 2; ++rh) *(u32x2*)(buf + r16 * 144 + (ni * 32 + rh * 16 + 4 * q) * 2) = vals(ni, rh);
#pragma unroll
    for (int jj = 0; jj < 2; ++jj) {
        const int row = (l >> 3) + 8 * jj;
        const u32x4 v = *(const u32x4*)(buf + row * 144 + (l & 7) * 16);
        *(u32x4*)(grow0 + (size_t)row * ld + (l & 7) * 8) = v;
    }
}

DI void ph_mla_in(const Params& P, int j, int vb, int nb, int tid, int dry = 0) {
    (void)dry;
    LANE_DECODE
    const bf16_t* Xb = (const bf16_t*)(P.ws + (j == 0 ? OFF_XB : OFF_XBN_B)); const bf16_t* W = (const bf16_t*)(P.ws + OFF_WB) + WB_MLA + j * W_MLA_SZ + W_MLA_IN;
    bf16_t* H = (bf16_t*)(P.ws + OFF_H); float* SSQ = (float*)(P.ws + OFF_SSQ); bf16_t* KR = (bf16_t*)(P.ws + OFF_KROPE);
    const float* COS = (const float*)(P.ws + OFF_COS); const float* SIN = (const float*)(P.ws + OFF_SIN);
    constexpr int NT = 7, MT = TT / 256;
    auto td = [&](int tile) { return mk_td(Xb, DM, (tile / NT) * 256, TT - 1, W, 1024, (tile % NT) * 128, 16); };
    constexpr int NTILES_ = MT * NT; int stg = 0; bool primed = false;
    for (int tile = vb; tile < MT * NT; tile += nb) {
        const int mt = tile / NT, nt = tile % NT;
        f32x16 acc[2][2];
        { const TD c_ = td(tile); const bool hn_ = tile + nb < NTILES_; const TD n_ = td(hn_ ? tile + nb : tile); mainloop_dma<0, true, 2>(acc, c_, n_, hn_, primed, stg, tid); primed = hn_; }
        const int wt = nt * 2 + wc;
        if (wt < 12) {
#pragma unroll
            for (int mi = 0; mi < 2; ++mi) {
                const int tok = mt * 256 + wr * 64 + mi * 32 + li; float ss = 0.f;
#pragma unroll
                for (int ni = 0; ni < 2; ++ni)
#pragma unroll
                    for (int g = 0; g < 4; ++g) {
                        const float a = acc[mi][ni][4 * g], b = acc[mi][ni][4 * g + 1], c = acc[mi][ni][4 * g + 2], d = acc[mi][ni][4 * g + 3];
                        ss += (a * a + b * b) + (c * c + d * d);
                        *(u32x2*)(H + (size_t)tok * 768 + wt * 64 + ni * 32 + 8 * g + 4 * h) = pk4(a, b, c, d);
                    }
                ss += __shfl_xor(ss, 32);
                if (h == 0) SSQ[tok * 12 + wt] = ss;
            }
        } else if (wt == 12) {
#pragma unroll
            for (int mi = 0; mi < 2; ++mi) {
                const int tok = mt * 256 + wr * 64 + mi * 32 + li;
#pragma unroll
                for (int g = 0; g < 4; ++g) {
                    const int i0 = 8 * g + 4 * h;
                    const f32x4 c4 = *(const f32x4*)(COS + tok * 32 + i0), s4 = *(const f32x4*)(SIN + tok * 32 + i0);
                    float o1[4], o2[4];
#pragma unroll
                    for (int c = 0; c < 4; ++c) { const float x1 = acc[mi][0][4 * g + c], x2 = acc[mi][1][4 * g + c]; o1[c] = x1 * c4[c] - x2 * s4[c]; o2[c] = x1 * s4[c] + x2 * c4[c]; }
                    *(u32x2*)(KR + (size_t)tok * 64 + i0) = pk4(o1[0], o1[1], o1[2], o1[3]);
                    *(u32x2*)(KR + (size_t)tok * 64 + 32 + i0) = pk4(o2[0], o2[1], o2[2], o2[3]);
                }
            }
        }
    }
}

DI void ph_mla_up(const Params& P, int j, int half, int vb, int nb, int tid, int dry = 0) {
    (void)dry;
    constexpr int MI = 4; typedef Cfg<MI> C;
    const bf16_t* H = (const bf16_t*)(P.ws + OFF_H); const float* SSQ = (const float*)(P.ws + OFF_SSQ);
    const bf16_t* WQ = (const bf16_t*)(P.ws + OFF_WB) + WB_MLA + j * W_MLA_SZ + W_MLA_UQ; const bf16_t* WKV = (const bf16_t*)(P.ws + OFF_WB) + WB_MLA + j * W_MLA_SZ + W_MLA_KV;
    bf16_t* Q = (bf16_t*)(P.ws + OFF_Q); bf16_t* KN = (bf16_t*)(P.ws + OFF_KN); bf16_t* VT = (bf16_t*)(P.ws + OFF_VT);
    const float* COS = (const float*)(P.ws + OFF_COS); const float* SIN = (const float*)(P.ws + OFF_SIN);
    constexpr int MT = HALF_T / 256, NTQ = 3072 / C::BN, NTKV = 4096 / C::BN, TQ = MT * NTQ, TKV = MT * NTKV;
    const float QSCALE = 0.07216878364870322f * 1.4426950408889634f;
    auto td = [&](int tile) {
        if (tile < TQ) return mk_td(H, 768, half * HALF_T + (tile / NTQ) * 256, TT - 1, WQ, 512, (tile % NTQ) * C::BN, 8);
        const int t2 = tile - TQ; return mk_td(H + 512, 768, half * HALF_T + (t2 / NTKV) * 256, TT - 1, WKV, 256, (t2 % NTKV) * C::BN, 4);
    };
    constexpr int NTILES_ = TQ + TKV; int stg = 0; bool primed = false;
    for (int tile = vb; tile < TQ + TKV; tile += nb) {
        f32x16 acc[MI][2];
        { const TD c_ = td(tile); const bool hn_ = tile + nb < NTILES_; const TD n_ = td(hn_ ? tile + nb : tile); mainloop_dma<0, true, MI>(acc, c_, n_, hn_, primed, stg, tid); primed = hn_; }
        LAUNDER_TID LANE_DECODE_E(MI)
        __syncthreads();
        char* ebuf = smem + (stg ^ 1) * C::STAGE + w * 4608;
        if (tile < TQ) {
            const int mt = tile / NTQ, nt = tile % NTQ, tok0 = half * HALF_T + mt * 256;
            const int wt = nt * C::NWC + wc, head = wt / 3, part = wt - head * 3;
#pragma unroll
            for (int mi = 0; mi < MI; ++mi) {
                const int tok = tok0 + wr * C::WROWS + mi * 32 + li, tl = tok - half * HALF_T;
                const f32x4 s0 = *(const f32x4*)(SSQ + tok * 12), s1 = *(const f32x4*)(SSQ + tok * 12 + 4);
                const float rs = __builtin_amdgcn_rsqf(((s0.x + s0.y) + (s0.z + s0.w) + (s1.x + s1.y) + (s1.z + s1.w)) * (1.f / 512.f) + EPS) * QSCALE;
                bf16_t* dst = Q + (size_t)tl * 3072 + head * 192 + part * 64;
                bf16_t* drow0 = Q + (size_t)(tok0 - half * HALF_T + wr * C::WROWS + mi * 32) * 3072 + head * 192 + part * 64;
                if (part < 2) {
                    wave_rows_store(ebuf, l, drow0, 3072, [&](int ni, int g) { return pk4(acc[mi][ni][4 * g] * rs, acc[mi][ni][4 * g + 1] * rs, acc[mi][ni][4 * g + 2] * rs, acc[mi][ni][4 * g + 3] * rs); });
                } else {
#pragma unroll
                    for (int g = 0; g < 4; ++g) {
                        const int i0 = 8 * g + 4 * h;
                        const f32x4 c4 = *(const f32x4*)(COS + tok * 32 + i0), s4 = *(const f32x4*)(SIN + tok * 32 + i0);
                        float o1[4], o2[4];
#pragma unroll
                        for (int c = 0; c < 4; ++c) { const float x1 = acc[mi][0][4 * g + c] * rs, x2 = acc[mi][1][4 * g + c] * rs; o1[c] = x1 * c4[c] - x2 * s4[c]; o2[c] = x1 * s4[c] + x2 * c4[c]; }
                        *(u32x2*)(dst + i0) = pk4(o1[0], o1[1], o1[2], o1[3]);
                        *(u32x2*)(dst + 32 + i0) = pk4(o2[0], o2[1], o2[2], o2[3]);
                    }
                }
            }
        } else {
            const int t2 = tile - TQ, mt = t2 / NTKV, nt = t2 % NTKV, tok0 = half * HALF_T + mt * 256;
            const int ncol0 = nt * C::BN + wc * 64;
#pragma unroll
            for (int mi = 0; mi < MI; ++mi) {
                const int tok = tok0 + wr * C::WROWS + mi * 32 + li, tl = tok - half * HALF_T;
                const f32x4 s0 = *(const f32x4*)(SSQ + tok * 12 + 8);
                const float rs = __builtin_amdgcn_rsqf(((s0.x + s0.y) + (s0.z + s0.w)) * (1.f / 256.f) + EPS);
                if (ncol0 < 2048) {
                    wave_rows_store(ebuf, l, KN + (size_t)(tok0 - half * HALF_T + wr * C::WROWS + mi * 32) * 2048 + ncol0, 2048,
                                    [&](int ni, int g) { return pk4(acc[mi][ni][4 * g] * rs, acc[mi][ni][4 * g + 1] * rs, acc[mi][ni][4 * g + 2] * rs, acc[mi][ni][4 * g + 3] * rs); });
                } else {
                    const int bl = tl >> 12, sq = tl & 4095;
#pragma unroll
                    for (int ni = 0; ni < 2; ++ni)
#pragma unroll
                        for (int r = 0; r < 16; ++r) {
                            const int n = ncol0 - 2048 + ni * 32 + 8 * (r >> 2) + 4 * h + (r & 3);
                            VT[((size_t)(bl * 2048 + n)) * 4096 + sq] = f2bf(acc[mi][ni][r] * rs);
                        }
                }
            }
        }
    }
}

template <int AMODE, bool PEND>
DI void ph_res(const Params& P, const bf16_t* A, int lda, int K, const bf16_t* W, int tokbase, int ntok, const float* lg, const float* lb, const float* Xsrc, int vb, int nb, int tid, int dry = 0) {
    constexpr int MI = 4; typedef Cfg<MI> C;
    float* X32 = P.out;
    const int MT = ntok / 256; constexpr int NT = 1024 / C::BN;
    auto td = [&](int tile) { return mk_td(A, lda, (tile / NT) * 256, ntok - 1, W, K, (tile % NT) * C::BN, K / 64); };
    const int NTILES_ = MT * NT; int stg = 0; bool primed = false;
    for (int tile = vb; tile < MT * NT; tile += nb) {
        const int mt = tile / NT, nt = tile % NT;
        f32x4 acc[MI][2][2][2];
        { const TD c_ = td(tile); const bool hn_ = tile + nb < NTILES_; const TD n_ = td(hn_ ? tile + nb : tile); mainloop_dma16<AMODE>(acc, c_, n_, hn_, primed, stg, tid); primed = hn_; }
        int tid_e = tid; asm volatile("" : "+v"(tid_e));
        const int l = tid_e & 63, w = tid_e >> 6, wr = w / C::NWC, wc = w % C::NWC, r16 = l & 15, q = l >> 4;
        const int colb = nt * C::BN + wc * 64 + 4 * q;
        f32x4 g4[2][2], b4[2][2];
        if (PEND) {
#pragma unroll
            for (int ni = 0; ni < 2; ++ni)
#pragma unroll
                for (int rh = 0; rh < 2; ++rh) { g4[ni][rh] = *(const f32x4*)(lg + colb + ni * 32 + rh * 16); b4[ni][rh] = *(const f32x4*)(lb + colb + ni * 32 + rh * 16); }
        }
        const int tokb = tokbase + mt * 256 + wr * C::WROWS + r16;
        f32x4 nx[2][2]; f32x2 nst = {0.f, 1.f};
        auto ldgrp = [&](int grp) {
            const int tok = tokb + (grp >> 1) * 32 + (grp & 1) * 16;
            if (PEND) nst = ((const f32x2*)(P.ws + OFF_STATS))[tok];
#pragma unroll
            for (int ni = 0; ni < 2; ++ni)
#pragma unroll
                for (int rh = 0; rh < 2; ++rh) nx[ni][rh] = *(const f32x4*)(Xsrc + (size_t)tok * DM + colb + ni * 32 + rh * 16);
        };
        ldgrp(0);
#pragma unroll
        for (int grp = 0; grp < 8; ++grp) {
            const int mi = grp >> 1, ch = grp & 1, tok = tokb + mi * 32 + ch * 16;
            f32x4 o[2][2]; const f32x2 st = nst;
#pragma unroll
            for (int ni = 0; ni < 2; ++ni)
#pragma unroll
                for (int rh = 0; rh < 2; ++rh) o[ni][rh] = nx[ni][rh];
            if (grp + 1 < 8) ldgrp(grp + 1);
#pragma unroll
            for (int ni = 0; ni < 2; ++ni)
#pragma unroll
                for (int rh = 0; rh < 2; ++rh) {
                    f32x4 v = o[ni][rh];
                    if (PEND) v = (v - st.x) * st.y * g4[ni][rh] + b4[ni][rh];
                    v = v * DN_ALPHA + acc[mi][ni][rh][ch];
                    if (!dry) *(f32x4*)(X32 + (size_t)tok * DM + colb + ni * 32 + rh * 16) = v;
                }
        }
    }
}

DI void ph_gla_in(const Params& P, int j, int vb, int nb, int tid, int dry = 0) {
    (void)dry;
    constexpr int MI = 4; typedef Cfg<MI> C;
    const bf16_t* Xb = (const bf16_t*)(P.ws + OFF_XBN_A); const bf16_t* W = (const bf16_t*)(P.ws + OFF_WB) + WB_GLA + j * W_GLA_SZ + W_GLA_IN;
    bf16_t* GQ = (bf16_t*)(P.ws + OFF_GQ); bf16_t* GK = (bf16_t*)(P.ws + OFF_GK); bf16_t* GVT = (bf16_t*)(P.ws + OFF_GVT); bf16_t* GR = (bf16_t*)(P.ws + OFF_GR); float* GA = (float*)(P.ws + OFF_GA);
    constexpr int NT = 13, MT = TT / 256;
    auto td = [&](int tile) { return mk_td(Xb, DM, (tile / NT) * 256, TT - 1, W, 1024, (tile % NT) * C::BN, 16); };
    constexpr int NTILES_ = MT * NT; int stg = 0; bool primed = false;
    for (int tile = vb; tile < MT * NT; tile += nb) {
        const int mt = tile / NT, nt = tile % NT;
        f32x4 acc[MI][2][2][2];
        const bool vtile = nt >= 4 && nt < 8;
        { const TD c_ = td(tile); const bool hn_ = tile + nb < NTILES_; const TD n_ = td(hn_ ? tile + nb : tile);
          if (vtile) mainloop_dma16<0, false>(acc, c_, n_, hn_, primed, stg, tid); else mainloop_dma16<0, true>(acc, c_, n_, hn_, primed, stg, tid);
          primed = hn_; }
        int tid_e = tid; asm volatile("" : "+v"(tid_e));
        const int l = tid_e & 63, w = tid_e >> 6, wr = w / C::NWC, wc = w % C::NWC, r16 = l & 15, q = l >> 4;
        __syncthreads();
        char* ebuf = smem + (stg ^ 1) * C::STAGE + w * 2304;
        if (vtile) {
#pragma unroll
            for (int mi = 0; mi < MI; ++mi)
#pragma unroll
                for (int ch = 0; ch < 2; ++ch) {
                    const int tok = mt * 256 + wr * C::WROWS + mi * 32 + ch * 16 + 4 * q, bb = tok >> 12, sq = tok & 4095;
#pragma unroll
                    for (int ni = 0; ni < 2; ++ni)
#pragma unroll
                        for (int rh = 0; rh < 2; ++rh) {
                            const int n = (nt * C::BN + wc * 64 - 1024) + ni * 32 + rh * 16 + r16;
                            const f32x4 v = acc[mi][ni][rh][ch];
                            *(u32x2*)(GVT + ((size_t)(bb * 1024 + n)) * 4096 + sq) = pk4(v.x, v.y, v.z, v.w);
                        }
                }
            continue;
        }
        const int wt = nt * C::NWC + wc;
#pragma unroll
        for (int mi = 0; mi < MI; ++mi)
#pragma unroll
            for (int ch = 0; ch < 2; ++ch) {
                const int tok = mt * 256 + wr * C::WROWS + mi * 32 + ch * 16 + r16;
                if (wt < 16) {
                    bf16_t* dst0 = (wt < 8 ? GQ + wt * 64 : GK + (wt - 8) * 64) + (size_t)(tok - r16) * 512;
                    const float sc = wt < 8 ? 0.08838834764831845f : 1.f;
                    wave_rows_store16(ebuf, l, dst0, 512, [&](int ni, int rh) { const f32x4 v = acc[mi][ni][rh][ch] * sc; return pk4(v.x, v.y, v.z, v.w); });
                } else if (wt < 32) {
                    const int bb = tok >> 12, sq = tok & 4095;
#pragma unroll
                    for (int ni = 0; ni < 2; ++ni)
#pragma unroll
                        for (int rh = 0; rh < 2; ++rh)
#pragma unroll
                            for (int r = 0; r < 4; ++r) {
                                const int n = (wt - 16) * 64 + ni * 32 + rh * 16 + 4 * q + r;
                                GVT[((size_t)(bb * 1024 + n)) * 4096 + sq] = f2bf(acc[mi][ni][rh][ch][r]);
                            }
                } else if (wt < 48) {
                    bf16_t* dst0 = GR + (size_t)(tok - r16) * 1024 + (wt - 32) * 64;
                    wave_rows_store16(ebuf, l, dst0, 1024, [&](int ni, int rh) { const f32x4 x = acc[mi][ni][rh][ch]; return pk4(x.x * sigmoidf_(x.x), x.y * sigmoidf_(x.y), x.z * sigmoidf_(x.z), x.w * sigmoidf_(x.w)); });
                } else if (wt == 48) {
                    *(f32x4*)(GA + (size_t)tok * 16 + 4 * q) = acc[mi][0][0][ch];
                }
            }
    }
}

DI void ph_ffn_up(const Params& P, int L, int vb, int nb, int tid, int dry = 0) {
    (void)dry;
    constexpr int MI = 4; typedef Cfg<MI> C;
    const bf16_t* Xb = (const bf16_t*)(P.ws + OFF_XB); const bf16_t* W = (const bf16_t*)(P.ws + OFF_WB) + WB_FFN + L * W_FFN_SZ + W_FFN_UP;
    bf16_t* GT = (bf16_t*)(P.ws + OFF_GATED);
    const float* cw = P.ffn_conv_w + (size_t)L * 3 * 5632; const float* cb = P.ffn_conv_b + (size_t)L * 5632;
    float* xch = (float*)(smem + XCH_OFF);
    constexpr int NT = 5632 / C::BN, MT = (TT + 253) / 254;
    auto tmap = [&](int lin, int& mt, int& nt) { const int panel = lin / (MT * 4), within = lin - panel * (MT * 4), pw = (NT - panel * 4) < 4 ? (NT - panel * 4) : 4; mt = within / pw; nt = panel * 4 + within % pw; };
    auto td = [&](int lin) { int mt, nt; tmap(lin, mt, nt); return mk_td(Xb, DM, mt * 254 - 2, TT - 1, W, 1024, nt * C::BN, 16); };
    constexpr int NTILES_ = MT * NT; int stg = 0; bool primed = false;
    for (int tile = vb; tile < MT * NT; tile += nb) {
        int mt, nt; tmap(tile, mt, nt);
        f32x4 acc[MI][2][2][2];
        { const TD c_ = td(tile); const bool hn_ = tile + nb < NTILES_; const TD n_ = td(hn_ ? tile + nb : tile); mainloop_dma16<0, false>(acc, c_, n_, hn_, primed, stg, tid); primed = hn_; }
        int tid_e = tid; asm volatile("" : "+v"(tid_e));
        const int l = tid_e & 63, w = tid_e >> 6, wr = w / C::NWC, wc = w % C::NWC, r16 = l & 15, q = l >> 4;
        const int wv = wr * C::NWC + wc, rot = (l + 48) & 63;
        if (q == 3) {
#pragma unroll
            for (int ug = 0; ug < 2; ++ug)
#pragma unroll
                for (int rh = 0; rh < 2; ++rh) {
                    xch[((((wv * 2 + 0) * 2 + ug) * 2 + rh) << 4) + r16] = acc[MI - 1][ug][rh][1][2];
                    xch[((((wv * 2 + 1) * 2 + ug) * 2 + rh) << 4) + r16] = acc[MI - 1][ug][rh][1][3];
                }
        }
        float wka[2][2][3], bka[2][2];
#pragma unroll
        for (int rh = 0; rh < 2; ++rh)
#pragma unroll
            for (int ug = 0; ug < 2; ++ug) {
                const int col = ug * DFF + (nt * C::NWC + wc) * 32 + rh * 16 + r16;
                wka[rh][ug][0] = cw[col]; wka[rh][ug][1] = cw[5632 + col]; wka[rh][ug][2] = cw[2 * 5632 + col]; bka[rh][ug] = cb[col];
            }
        asm volatile("s_waitcnt vmcnt(0)" ::: "memory");
        __syncthreads();
        const int tlo = (mt * 254 - 2) < 0 ? 0 : (mt * 254 - 2), rlo = tlo & 4095;
        const bool has_start = (rlo <= 1) || (rlo + 256 > 4096);
        auto epi = [&](auto padc) {
        constexpr bool PAD = decltype(padc)::value;
#pragma unroll
        for (int rh = 0; rh < 2; ++rh) {
            const int cu = (nt * C::NWC + wc) * 32 + rh * 16 + r16;
            float wk[2][3], bk[2], c2[2], c3[2];
#pragma unroll
            for (int ug = 0; ug < 2; ++ug) {
                wk[ug][0] = wka[rh][ug][0]; wk[ug][1] = wka[rh][ug][1]; wk[ug][2] = wka[rh][ug][2]; bk[ug] = bka[rh][ug];
                c2[ug] = wr > 0 ? xch[(((((wv - C::NWC) * 2 + 0) * 2 + ug) * 2 + rh) << 4) + r16] : 0.f;
                c3[ug] = wr > 0 ? xch[(((((wv - C::NWC) * 2 + 1) * 2 + ug) * 2 + rh) << 4) + r16] : 0.f;
            }
#pragma unroll
            for (int mi = 0; mi < MI; ++mi)
#pragma unroll
                for (int ch = 0; ch < 2; ++ch) {
                    const int i0 = wr * C::WROWS + mi * 32 + ch * 16 + 4 * q;
                    const int t0 = mt * 254 - 2 + i0;
                    float y[2][4];
#pragma unroll
                    for (int ug = 0; ug < 2; ++ug) {
                        const f32x4 x = acc[mi][ug][rh][ch];
                        const float r2 = __shfl(x[2], rot), r3 = __shfl(x[3], rot);
                        const float pm2 = q ? r2 : c2[ug], pm1 = q ? r3 : c3[ug];
                        c2[ug] = r2; c3[ug] = r3;
                        const float vals[6] = {pm2, pm1, x[0], x[1], x[2], x[3]};
#pragma unroll
                        for (int c = 0; c < 4; ++c) {
                            const int sq = (t0 + c) & 4095;
                            const float t1 = (!PAD || sq >= 1) ? vals[c + 1] : 0.f, t2 = (!PAD || sq >= 2) ? vals[c] : 0.f;
                            y[ug][c] = __builtin_fmaf(wk[ug][0], t2, __builtin_fmaf(wk[ug][1], t1, __builtin_fmaf(wk[ug][2], vals[c + 2], bk[ug])));
                        }
                    }
                    const int goff = t0 * DFF + cu;
                    if (mt < MT - 1 && (mi | ch) != 0) {
#pragma unroll
                        for (int c = 0; c < 4; ++c) GT[goff + c * DFF] = f2bf(y[0][c] * gelu_tanh(y[1][c]));
                    } else {
#pragma unroll
                        for (int c = 0; c < 4; ++c) {
                            const int t = t0 + c;
                            if (i0 + c >= 2 && t < TT) GT[goff + c * DFF] = f2bf(y[0][c] * gelu_tanh(y[1][c]));
                        }
                    }
                }
        }
        };
        if (has_start) epi(std::true_type{}); else epi(std::false_type{});
    }
}

DI void ph_ple(const Params& P, int L, const float* lg, const float* lb, int vb, int nb, int tid, int dry = 0) {
    LANE_DECODE
    const bf16_t* Xbc = (const bf16_t*)(P.ws + OFF_XB); bf16_t* Xb = (bf16_t*)(P.ws + OFF_XB);
    const bf16_t* WG = (const bf16_t*)(P.ws + OFF_WB) + WB_PLE + L * W_PLE_SZ + W_PLE_G; const bf16_t* WP = (const bf16_t*)(P.ws + OFF_WB) + WB_PLE + L * W_PLE_SZ + W_PLE_P;
    const float* pp = P.p + (size_t)L * TT * 256; const float* bg = P.ple_b_gate + L * 1024;
    float* X32 = P.out;
    constexpr int NT = 8, MT = TT / 256;
    bf16_t* XB2 = (bf16_t*)(P.ws + ((L & 1) ? OFF_XBN_B : OFF_XBN_A));
    for (int tile = vb; tile < MT * NT; tile += nb) {
        const int mt = tile / NT, nt = tile % NT;
        f32x16 accg[2][2];
        unsigned pp2[2][2][8];
        {
            f32x16 accp[2][2];
            mainloop<true, 0, true>(accp, pp, 256, mt * 256, TT - 1, WP, 256, nt * 128, 4, tid);
#pragma unroll
            for (int mi = 0; mi < 2; ++mi)
#pragma unroll
                for (int ni = 0; ni < 2; ++ni)
#pragma unroll
                    for (int q = 0; q < 8; ++q) pp2[mi][ni][q] = pk2(accp[mi][ni][2 * q], accp[mi][ni][2 * q + 1]);
        }
        mainloop<false, 0, true>(accg, Xbc, DM, mt * 256, TT - 1, WG, 1024, nt * 128, 16, tid);
        const int tokA = mt * 256 + wr * 64 + li;
        f32x2 st2[2];
#pragma unroll
        for (int mi = 0; mi < 2; ++mi) st2[mi] = ((const f32x2*)(P.ws + OFF_STATS))[tokA + mi * 32];
        const int colq = nt * 128 + wc * 64 + 4 * h;
        f32x4 nb4, ng4, nl4, nx[2];
        auto ldq = [&](int k) {
            const int col = colq + (k >> 2) * 32 + (k & 3) * 8;
            nb4 = *(const f32x4*)(bg + col); ng4 = *(const f32x4*)(lg + col); nl4 = *(const f32x4*)(lb + col);
#pragma unroll
            for (int mi = 0; mi < 2; ++mi) nx[mi] = *(const f32x4*)(X32 + (size_t)(tokA + mi * 32) * DM + col);
        };
        ldq(0);
#pragma unroll
        for (int k = 0; k < 8; ++k) {
            const int ni = k >> 2, g = k & 3, col = colq + ni * 32 + g * 8;
            const f32x4 b4 = nb4, g4 = ng4, bl4 = nl4; f32x4 xo[2];
#pragma unroll
            for (int mi = 0; mi < 2; ++mi) xo[mi] = nx[mi];
            if (k + 1 < 8) ldq(k + 1);
#pragma unroll
            for (int mi = 0; mi < 2; ++mi) {
                const unsigned p01 = pp2[mi][ni][2 * g], p23 = pp2[mi][ni][2 * g + 1];
                f32x4 o = (xo[mi] - st2[mi].x) * st2[mi].y * g4 + bl4;
                o.x += sigmoidf_(accg[mi][ni][4 * g] + b4.x) * bf2f(p01 & 0xffffu);
                o.y += sigmoidf_(accg[mi][ni][4 * g + 1] + b4.y) * bf2f(p01 >> 16);
                o.z += sigmoidf_(accg[mi][ni][4 * g + 2] + b4.z) * bf2f(p23 & 0xffffu);
                o.w += sigmoidf_(accg[mi][ni][4 * g + 3] + b4.w) * bf2f(p23 >> 16);
                if (!dry) { *(f32x4*)(X32 + (size_t)(tokA + mi * 32) * DM + col) = o; *(u32x2*)(XB2 + (size_t)(tokA + mi * 32) * DM + col) = pk4(o.x, o.y, o.z, o.w); }
            }
        }
    }
    (void)Xb;
}

DI void ph_copy_xb(const Params& P, int vb, int nb, int tid, int dry = 0) {
    (void)dry;
    const u32x4* s = (const u32x4*)(P.ws + OFF_GATED); u32x4* d = (u32x4*)(P.ws + OFF_XB);
    const int n = TT * DM / 8;
    for (int i = vb * NTH + tid; i < n; i += nb * NTH) d[i] = s[i];
}

DI void ph_attn(const Params& P, int half, int vb, int nb, int tid, int dry = 0) {
    const int l = tid & 63, w = tid >> 6, r16 = l & 15, qq = l >> 4;
    bf16_t* Q = (bf16_t*)(P.ws + OFF_Q); const bf16_t* KN = (const bf16_t*)(P.ws + OFF_KN); const bf16_t* VT = (const bf16_t*)(P.ws + OFF_VT); const bf16_t* KR = (const bf16_t*)(P.ws + OFF_KROPE);
    const int* CID = (const int*)(P.ws + OFF_CID); const int* TMIN = (const int*)(P.ws + OFF_TMIN); const int* TMAX = (const int*)(P.ws + OFF_TMAX);
    const int krow0 = 8 * (r16 >> 2) + (r16 & 3);
    const int kkey = 2 * ((r16 >> 1) & 1) + 4 * ((r16 >> 3) & 1);
    const int vkey = (r16 >> 1) & 7;
    for (int u = vb; u < 1024; u += nb) {
        const int r = u >> 8, v = u & 255, xcd = v >> 5, slot = v & 31, gq = slot & 3, rw = (r + ((slot >> 2) & 3)) & 3;
        const int bh = xcd * 8 + 2 * r + (slot >> 4), bl = bh >> 4, head = bh & 15;
        const int qt = (rw == 0) ? 15 - gq : (rw == 1) ? 8 + gq : (rw == 2) ? 7 - gq : gq;
        const int q0 = qt * 256, nkt = 4 * qt + 4;
        const int tlb = bl * 4096, gtb = half * HALF_T + tlb;
        const int q1w = (((q0 + w * 32) >> 7) + 1) << 7;
        const int qs0 = q0 + w * 32 + r16;
        bf16x8 qf[6][2];
#pragma unroll
        for (int ds = 0; ds < 6; ++ds)
#pragma unroll
            for (int qb = 0; qb < 2; ++qb) qf[ds][qb] = *(const bf16x8*)(Q + (size_t)(tlb + qs0 + 16 * qb) * 3072 + head * 192 + ds * 32 + qq * 8);
        int tminq = TMIN[(gtb + q0) >> 6];
#pragma unroll
        for (int i = 1; i < 4; ++i) tminq = min(tminq, TMIN[((gtb + q0) >> 6) + i]);
        float m[2] = {-1e30f, -1e30f}, lsum[2] = {0.f, 0.f};
        f32x4 ao[8][2];
#pragma unroll
        for (int d = 0; d < 8; ++d)
#pragma unroll
            for (int qb = 0; qb < 2; ++qb) ao[d][qb] = (f32x4){0.f, 0.f, 0.f, 0.f};
        unsigned koff[3], kst[3], voff[2];
#pragma unroll
        for (int i = 0; i < 3; ++i) {
            const int bb = 1024 * (3 * w + i) + 16 * l, rw = bb / 384, pc = (bb - 384 * rw) >> 4, c = (pc & 24) | ((pc ^ (2 * ((rw >> 1) & 1) + 4 * ((rw >> 4) & 1))) & 7);
            if (c < 16) { koff[i] = (unsigned)(OFF_KN + ((size_t)(tlb + rw) * 2048 + head * 128 + c * 8) * 2); kst[i] = 64 * 2048 * 2; }
            else { koff[i] = (unsigned)(OFF_KROPE + ((size_t)(gtb + rw) * 64 + (c - 16) * 8) * 2); kst[i] = 64 * 64 * 2; }
        }
#pragma unroll
        for (int i = 0; i < 2; ++i) {
            const int row = 8 * (2 * w + i) + (l >> 3), c = (l & 7) ^ ((row >> 1) & 7);
            voff[i] = (unsigned)(OFF_VT + (((size_t)(bl * 2048 + head * 128 + row)) * 4096 + c * 8) * 2);
        }
        auto issue = [&](int kt, int st) {
            char* sb = smem + st * AT_STAGE;
#pragma unroll
            for (int i = 0; i < 3; ++i)
                __builtin_amdgcn_global_load_lds((const __attribute__((address_space(1))) void*)(P.ws + (koff[i] + (unsigned)kt * kst[i])), (__attribute__((address_space(3))) void*)(sb + (3 * w + i) * 1024), 16, 0, 0);
#pragma unroll
            for (int i = 0; i < 2; ++i)
                __builtin_amdgcn_global_load_lds((const __attribute__((address_space(1))) void*)(P.ws + (voff[i] + (unsigned)kt * 128u)), (__attribute__((address_space(3))) void*)(sb + AT_KB + (2 * w + i) * 1024), 16, 0, 0);
        };
        __syncthreads();
        issue(0, 0); asm volatile("s_waitcnt vmcnt(0)" ::: "memory"); __syncthreads();
        for (int kt = 0; kt < nkt; ++kt) {
            const bool more = kt + 1 < nkt;
            if (more) issue(kt + 1, (kt + 1) & 1);
            const char* sb = smem + (kt & 1) * AT_STAGE;
            if (kt * 64 < q1w) {
            f32x4 as[4][2];
#pragma unroll
            for (int kb = 0; kb < 4; ++kb)
#pragma unroll
                for (int qb = 0; qb < 2; ++qb) as[kb][qb] = (f32x4){0.f, 0.f, 0.f, 0.f};
#pragma unroll
            for (int ds = 0; ds < 6; ++ds) {
                const int ch = 4 * ds + qq;
#pragma unroll
                for (int kb = 0; kb < 4; ++kb) {
                    const int krow = krow0 + 32 * (kb >> 1) + 4 * (kb & 1), key = kkey;
                    const bf16x8 kf = *(const bf16x8*)(sb + krow * 384 + (((ch & 24) | ((ch ^ key) & 7)) << 4));
#pragma unroll
                    for (int qb = 0; qb < 2; ++qb) as[kb][qb] = MFMA16(kf, qf[ds][qb], as[kb][qb]);
                }
            }
            const bool need_mask = (kt >= 4 * qt) || (TMAX[((gtb) >> 6) + kt] > tminq);
            if (need_mask) {
#pragma unroll
                for (int qb = 0; qb < 2; ++qb) {
                    const int qsr = qs0 + 16 * qb, cidq = CID[gtb + qsr], q1lim = ((qsr >> 7) + 1) << 7;
#pragma unroll
                    for (int k2 = 0; k2 < 2; ++k2) {
                        const int kbase = kt * 64 + 32 * k2 + 8 * qq;
                        const i32x4 c0 = *(const i32x4*)(CID + gtb + kbase), c1 = *(const i32x4*)(CID + gtb + kbase + 4);
#pragma unroll
                        for (int rr = 0; rr < 4; ++rr) {
                            if (!((kbase + rr < q1lim) && (c0[rr] <= cidq))) as[2 * k2][qb][rr] = -1e30f;
                            if (!((kbase + 4 + rr < q1lim) && (c1[rr] <= cidq))) as[2 * k2 + 1][qb][rr] = -1e30f;
                        }
                    }
                }
            }
            float alpha[2];
#pragma unroll
            for (int qb = 0; qb < 2; ++qb) {
                float mx = as[0][qb][0];
#pragma unroll
                for (int kb = 0; kb < 4; ++kb)
#pragma unroll
                    for (int rr = 0; rr < 4; ++rr) mx = fmaxf(mx, as[kb][qb][rr]);
                mx = fmaxf(mx, __shfl_xor(mx, 16)); mx = fmaxf(mx, __shfl_xor(mx, 32));
                const float mnew = fmaxf(m[qb], mx);
                alpha[qb] = fexp2(m[qb] - mnew); m[qb] = mnew;
                float ps = 0.f;
#pragma unroll
                for (int kb = 0; kb < 4; ++kb)
#pragma unroll
                    for (int rr = 0; rr < 4; ++rr) { const float pv = fexp2(as[kb][qb][rr] - mnew); as[kb][qb][rr] = pv; ps += pv; }
                lsum[qb] = lsum[qb] * alpha[qb] + ps;
            }
            if (__builtin_amdgcn_ballot_w64(alpha[0] != 1.f || alpha[1] != 1.f) != 0ull) {
#pragma unroll
                for (int d = 0; d < 8; ++d)
#pragma unroll
                    for (int qb = 0; qb < 2; ++qb) ao[d][qb] = ao[d][qb] * alpha[qb];
            }
            bf16x8 pf[2][2];
#pragma unroll
            for (int k2 = 0; k2 < 2; ++k2)
#pragma unroll
                for (int qb = 0; qb < 2; ++qb) {
                    u32x4 pkd;
                    pkd.x = pk2(as[2 * k2][qb][0], as[2 * k2][qb][1]); pkd.y = pk2(as[2 * k2][qb][2], as[2 * k2][qb][3]);
                    pkd.z = pk2(as[2 * k2 + 1][qb][0], as[2 * k2 + 1][qb][1]); pkd.w = pk2(as[2 * k2 + 1][qb][2], as[2 * k2 + 1][qb][3]);
                    pf[k2][qb] = __builtin_bit_cast(bf16x8, pkd);
                }
#pragma unroll
            for (int k2 = 0; k2 < 2; ++k2) {
                const int ph = ((4 * k2 + qq) ^ vkey) << 4;
#pragma unroll
                for (int d = 0; d < 8; ++d) {
                    const bf16x8 vf = *(const bf16x8*)(sb + AT_KB + (d * 16 + r16) * 128 + ph);
#pragma unroll
                    for (int qb = 0; qb < 2; ++qb) ao[d][qb] = MFMA16(vf, pf[k2][qb], ao[d][qb]);
                }
            }
            }
            asm volatile("s_waitcnt vmcnt(0)" ::: "memory");
            __syncthreads();
        }
        if (!dry) {
#pragma unroll
            for (int qb = 0; qb < 2; ++qb) {
                float ls = lsum[qb]; ls += __shfl_xor(ls, 16); ls += __shfl_xor(ls, 32);
                const float inv = frcp(ls);
                bf16_t* orow = Q + (size_t)(tlb + qs0 + 16 * qb) * 3072 + head * 192 + 4 * qq;
#pragma unroll
                for (int d = 0; d < 8; ++d) { const f32x4 o = ao[d][qb] * inv; *(u32x2*)(orow + d * 16) = pk4(o.x, o.y, o.z, o.w); }
            }
        }
    }
}

DI void ph_gla_scan(const Params& P, int j, int vb, int nb, int tid, int dry = 0) {
    (void)dry;
    const int l = tid & 63, w = tid >> 6;
    const float* GA = (const float*)(P.ws + OFF_GA); const bf16_t* GK = (const bf16_t*)(P.ws + OFF_GK); const bf16_t* GVT = (const bf16_t*)(P.ws + OFF_GVT); bf16_t* ST = (bf16_t*)(P.ws + OFF_ST);
    const float* w2 = P.gla_w_a2 + (size_t)j * 16 * 512; const float* ba = P.gla_b_a + j * 512;
    bf16_t* kdl = (bf16_t*)smem;
    float* decl = (float*)(smem + 4096);
    for (int u = vb; u < 256; u += nb) {
        const int b = u >> 5, hh = (u >> 3) & 3, ksl = u & 7;
        const int kc0 = hh * 128 + ksl * 16 + 2 * w;
        float wa[2][16], bb[2];
#pragma unroll
        for (int e = 0; e < 2; ++e) { bb[e] = ba[kc0 + e];
#pragma unroll
            for (int jj = 0; jj < 16; ++jj) wa[e][jj] = w2[jj * 512 + kc0 + e]; }
        f32x4 acc[2];
#pragma unroll
        for (int e = 0; e < 2; ++e) acc[e] = (f32x4){0.f, 0.f, 0.f, 0.f};
        __syncthreads();
        f32x4 a4n[4]; unsigned krawn; bf16x8 vfrn[2][2];
        auto ldchunk = [&](int n) {
            const int tok = b * 4096 + n * 64 + l;
#pragma unroll
            for (int q = 0; q < 4; ++q) a4n[q] = *(const f32x4*)(GA + (size_t)tok * 16 + 4 * q);
            krawn = *(const unsigned*)(GK + (size_t)tok * 512 + kc0);
#pragma unroll
            for (int e = 0; e < 2; ++e)
#pragma unroll
                for (int ks = 0; ks < 2; ++ks)
                    vfrn[e][ks] = *(const bf16x8*)(GVT + ((size_t)(b * 1024 + hh * 256 + (2 * w + e) * 16 + (l & 15))) * 4096 + n * 64 + ks * 32 + (l >> 4) * 8);
        };
        ldchunk(0);
        for (int n = 0; n < 64; ++n) {
            const int buf = n & 1;
            f32x4 a4[4]; bf16x8 vfr[2][2];
#pragma unroll
            for (int q = 0; q < 4; ++q) a4[q] = a4n[q];
            const unsigned kraw = krawn;
#pragma unroll
            for (int e = 0; e < 2; ++e)
#pragma unroll
                for (int ks = 0; ks < 2; ++ks) vfr[e][ks] = vfrn[e][ks];
            if (n + 1 < 64) ldchunk(n + 1);
            float cum[2];
#pragma unroll
            for (int e = 0; e < 2; ++e) {
                float z = bb[e];
#pragma unroll
                for (int q = 0; q < 4; ++q) { z += a4[q].x * wa[e][4 * q] + a4[q].y * wa[e][4 * q + 1] + a4[q].z * wa[e][4 * q + 2] + a4[q].w * wa[e][4 * q + 3]; }
                cum[e] = (fminf(z, 0.f) - __logf(1.f + __expf(-fabsf(z)))) * (1.f / 16.f);
            }
#pragma unroll
            for (int o = 1; o < 64; o <<= 1) {
                const float t0 = __shfl_up(cum[0], o), t1 = __shfl_up(cum[1], o);
                if (l >= o) { cum[0] += t0; cum[1] += t1; }
            }
            const float tot0 = __shfl(cum[0], 63), tot1 = __shfl(cum[1], 63);
            kdl[(buf * 16 + 2 * w) * 64 + l] = f2bf(bf2f(kraw & 0xffffu) * __expf(tot0 - cum[0]));
            kdl[(buf * 16 + 2 * w + 1) * 64 + l] = f2bf(bf2f(kraw >> 16) * __expf(tot1 - cum[1]));
            if (l == 0) { decl[buf * 16 + 2 * w] = __expf(tot0); decl[buf * 16 + 2 * w + 1] = __expf(tot1); }
            __syncthreads();
            const f32x4 d4 = *(const f32x4*)(decl + buf * 16 + (l >> 4) * 4);
#pragma unroll
            for (int e = 0; e < 2; ++e) acc[e] = acc[e] * d4;
#pragma unroll
            for (int ks = 0; ks < 2; ++ks) {
                const bf16x8 af = *(const bf16x8*)(kdl + (buf * 16 + (l & 15)) * 64 + ks * 32 + (l >> 4) * 8);
#pragma unroll
                for (int e = 0; e < 2; ++e) acc[e] = MFMA16(af, vfr[e][ks], acc[e]);
            }
            const int cidx = b * 64 + n;
#pragma unroll
            for (int e = 0; e < 2; ++e) {
                const int vv = (2 * w + e) * 16 + (l & 15);
                *(u32x2*)(ST + (((size_t)(cidx * 4 + hh)) * 256 + vv) * 128 + ksl * 16 + (l >> 4) * 4) = pk4(acc[e].x, acc[e].y, acc[e].z, acc[e].w);
            }
        }
    }
}

DI void ph_gla_out(const Params& P, int j, int vb, int nb, int tid, int dry = 0) {
    (void)dry;
    LANE_DECODE
    const bf16_t* GQ = (const bf16_t*)(P.ws + OFF_GQ); const bf16_t* ST = (const bf16_t*)(P.ws + OFF_ST); const bf16_t* GR = (const bf16_t*)(P.ws + OFF_GR); bf16_t* OG = (bf16_t*)(P.ws + OFF_OG);
    const float* on = P.gla_o_norm + j * 1024;
    f32x2* red = (f32x2*)smem;
    for (int u = vb; u < 2048; u += nb) {
        const int cidx = u >> 2, hh = u & 3, tok0 = cidx * 64;
        bf16x8 bfr[8], afr[2][8];
#pragma unroll
        for (int ks = 0; ks < 8; ++ks) {
            bfr[ks] = *(const bf16x8*)(ST + (((size_t)(cidx * 4 + hh)) * 256 + 32 * w + li) * 128 + ks * 16 + h * 8);
#pragma unroll
            for (int mi = 0; mi < 2; ++mi) afr[mi][ks] = *(const bf16x8*)(GQ + (size_t)(tok0 + mi * 32 + li) * 512 + hh * 128 + ks * 16 + h * 8);
        }
        f32x4 gn[4]; u32x2 rr[2][4];
#pragma unroll
        for (int g = 0; g < 4; ++g) {
            const int v0 = hh * 256 + 32 * w + 8 * g + 4 * h;
            gn[g] = *(const f32x4*)(on + v0);
#pragma unroll
            for (int mi = 0; mi < 2; ++mi) rr[mi][g] = *(const u32x2*)(GR + (size_t)(tok0 + mi * 32 + li) * 1024 + v0);
        }
        f32x16 acc[2];
#pragma unroll
        for (int mi = 0; mi < 2; ++mi)
#pragma unroll
            for (int i = 0; i < 16; ++i) acc[mi][i] = 0.f;
#pragma unroll
        for (int ks = 0; ks < 8; ++ks)
#pragma unroll
            for (int mi = 0; mi < 2; ++mi) acc[mi] = MFMA32(bfr[ks], afr[mi][ks], acc[mi]);
#pragma unroll
        for (int mi = 0; mi < 2; ++mi) {
            float s1 = 0.f, s2 = 0.f;
#pragma unroll
            for (int i = 0; i < 16; ++i) { s1 += acc[mi][i]; s2 += acc[mi][i] * acc[mi][i]; }
            s1 += __shfl_xor(s1, 32); s2 += __shfl_xor(s2, 32);
            if (h == 0) red[w * 64 + mi * 32 + li] = (f32x2){s1, s2};
        }
        __syncthreads();
#pragma unroll
        for (int mi = 0; mi < 2; ++mi) {
            float s1 = 0.f, s2 = 0.f;
#pragma unroll
            for (int ww = 0; ww < 8; ++ww) { const f32x2 t = red[ww * 64 + mi * 32 + li]; s1 += t.x; s2 += t.y; }
            const float mean = s1 * (1.f / 256.f), var = fmaxf(s2 * (1.f / 256.f) - mean * mean, 0.f), rstd = __builtin_amdgcn_rsqf(var + EPS);
            const int tok = tok0 + mi * 32 + li;
#pragma unroll
            for (int g = 0; g < 4; ++g) {
                const int v0 = hh * 256 + 32 * w + 8 * g + 4 * h;
                const u32x2 r2 = rr[mi][g];
                const float o0 = (acc[mi][4 * g] - mean) * rstd * gn[g].x * bf2f(r2.x & 0xffffu), o1 = (acc[mi][4 * g + 1] - mean) * rstd * gn[g].y * bf2f(r2.x >> 16);
                const float o2 = (acc[mi][4 * g + 2] - mean) * rstd * gn[g].z * bf2f(r2.y & 0xffffu), o3 = (acc[mi][4 * g + 3] - mean) * rstd * gn[g].w * bf2f(r2.y >> 16);
                *(u32x2*)(OG + (size_t)tok * 1024 + v0) = pk4(o0, o1, o2, o3);
            }
        }
        __syncthreads();
    }
}

#define XB_TMO      128
#define XB_XCNT(j)  (256  + 64 * (j))
#define XB_XSUB(j)  (1280 + 64 * (j))
#define XB_XGEN(j)  (2304 + 64 * (j))
#define XB_TOP      3328
#define XB_TOPGEN   3392
#define XCD_BAR_WORDS 3456
#define XB_SPIN_CAP (1u << 20)
#define LAS __attribute__((address_space(3)))
DI unsigned xb_ld(unsigned* p)              { return __hip_atomic_load(p, __ATOMIC_RELAXED, __HIP_MEMORY_SCOPE_AGENT); }
DI unsigned xb_add(unsigned* p, unsigned v) { return __hip_atomic_fetch_add(p, v, __ATOMIC_RELAXED, __HIP_MEMORY_SCOPE_AGENT); }
DI unsigned xb_xcc_id() { return (unsigned)__builtin_amdgcn_s_getreg((3 << 11) | 20) & 0xFu; }
#define XB_SPIN(cond, bar) do { unsigned _sp = 0; while (cond) { __builtin_amdgcn_s_sleep(1); \
    if ((++_sp & 255u) == 0u) { if (xb_ld(&(bar)[XB_TMO])) break; if (_sp > XB_SPIN_CAP) { atomicAdd(&(bar)[XB_TMO], 1u); break; } } } } while (0)
struct XcdBarrier { unsigned* bar; unsigned x; volatile LAS unsigned* st; };
DI XcdBarrier xcd_barrier_post(unsigned* bar, volatile LAS unsigned* st) {
    XcdBarrier b; b.bar = bar; b.x = xb_xcc_id(); b.st = st;
    if (threadIdx.x == 0) (void)xb_add(&bar[XB_XCNT(b.x)], 1u);
    return b;
}
DI void xcd_barrier_complete(unsigned* bar, unsigned x, unsigned& nloc, unsigned& nx) {
    const unsigned G = gridDim.x * gridDim.y * gridDim.z;
    unsigned sum, cnt, mine, sp = 0u;
    for (;;) {
        sum = 0u; cnt = 0u; mine = 0u;
#pragma unroll
        for (unsigned j = 0; j < 16; ++j) { const unsigned c = xb_ld(&bar[XB_XCNT(j)]); sum += c; cnt += (c > 0u) ? 1u : 0u; mine = (j == x) ? c : mine; }
        if (sum == G) break;
        __builtin_amdgcn_s_sleep(1);
        if ((++sp & 255u) == 0u) { if (xb_ld(&bar[XB_TMO])) break; if (sp > XB_SPIN_CAP) { atomicAdd(&bar[XB_TMO], 1u); break; } }
    }
    nloc = mine > 0u ? mine : 1u; nx = cnt > 0u ? cnt : 1u;
}
DI void xcd_barrier(const XcdBarrier& b) {
    asm volatile("s_waitcnt vmcnt(0)" ::: "memory");
    __syncthreads();
    if (threadIdx.x == 0) {
        unsigned* bar = b.bar;
        __builtin_amdgcn_s_waitcnt(0);
        unsigned nloc = b.st[0], nx = b.st[1];
        if (nloc == 0u) { xcd_barrier_complete(bar, b.x, nloc, nx); b.st[0] = nloc; b.st[1] = nx; }
        const unsigned old = xb_add(&bar[XB_XSUB(b.x)], 1u);
        const unsigned gen = old / nloc;
        if (old + 1u == (gen + 1u) * nloc) {
            __builtin_amdgcn_fence(__ATOMIC_RELEASE, "agent");
            asm volatile("s_waitcnt vmcnt(0)" ::: "memory");
            const unsigned og = xb_add(&bar[XB_TOP], 1u);
            const unsigned tg = og / nx;
            if (og + 1u == (tg + 1u) * nx) xb_add(&bar[XB_TOPGEN], 1u);
            else XB_SPIN(xb_ld(&bar[XB_TOPGEN]) == tg, bar);
            __builtin_amdgcn_fence(__ATOMIC_ACQUIRE, "agent");
            xb_add(&bar[XB_XGEN(b.x)], 1u);
            asm volatile("s_waitcnt vmcnt(0)" ::: "memory");
        } else {
            XB_SPIN(xb_ld(&bar[XB_XGEN(b.x)]) == gen, bar);
            __builtin_amdgcn_fence(__ATOMIC_ACQUIRE, "agent");
            asm volatile("s_waitcnt vmcnt(0)" ::: "memory");
        }
    }
    __syncthreads();
}

__global__ void __launch_bounds__(NTH) mega(Params P) {
    cg::grid_group grid = cg::this_grid();
    const int tid0 = threadIdx.x, nb = gridDim.x, bid = blockIdx.x;
    const int vb0 = ((nb & 7) == 0) ? (bid & 7) * (nb >> 3) + (bid >> 3) : bid;
    int ph = 0;
    const int lo = P.ph_lo, hi = P.ph_hi;
    __shared__ uint4 xb_words;
    if (tid0 == 0) xb_words = make_uint4(0u, 0u, 0u, 0u);
    __syncthreads();
    const XcdBarrier xb = xcd_barrier_post((unsigned*)(P.ws + OFF_BAR), (volatile LAS unsigned*)&xb_words);
#define GSYNC() { if (ph == 0) grid.sync(); else xcd_barrier(xb); }
#define PHASE1(body) { int tid = tid0, vb = vb0; asm volatile("" : "+v"(tid)); asm volatile("" : "+s"(vb)); body; }
#define PHASE(cls, fn, ...) { if (ph >= lo && ph < hi) { if ((PROBE_MASK >> cls) & 1) { PHASE1(fn(__VA_ARGS__, P.dry)) xcd_barrier(xb); } PHASE1(fn(__VA_ARGS__)) if (ph + 1 < hi) GSYNC() } ++ph; }
    if ((PROBE_MASK >> 11) & 1) { for (int i = 0; i < 50; ++i) xcd_barrier(xb); }
    PHASE(0, prologue, P, vb, nb, tid)
    for (int L = 0; L < 4; ++L) {
        const int j = L >> 1;
        const float* g1 = P.ln1_g + L * 1024; const float* b1 = P.ln1_b + L * 1024; const float* g2 = P.ln2_g + L * 1024; const float* b2 = P.ln2_b + L * 1024;
        if ((L & 1) == 0) {
            PHASE(1, ph_mla_in, P, j, vb, nb, tid)
            for (int half = 0; half < 2; ++half) {
                PHASE(1, ph_mla_up, P, j, half, vb, nb, tid)
                PHASE(2, ph_attn, P, half, vb, nb, tid)
                PHASE(3, (ph_res<1, false>), P, (const bf16_t*)(P.ws + OFF_Q), 3072, 2048, (const bf16_t*)(P.ws + OFF_WB) + WB_MLA + j * W_MLA_SZ + W_MLA_O, half * HALF_T, HALF_T, g1, b1, (L == 0 ? P.x : (const float*)P.out), vb, nb, tid)
            }
        } else {
            PHASE(1, ph_gla_in, P, j, vb, nb, tid)
            PHASE(9, ph_gla_scan, P, j, vb, nb, tid)
            PHASE(10, ph_gla_out, P, j, vb, nb, tid)
            PHASE(3, (ph_res<0, false>), P, (const bf16_t*)(P.ws + OFF_OG), 1024, 1024, (const bf16_t*)(P.ws + OFF_WB) + WB_GLA + j * W_GLA_SZ + W_GLA_O, 0, TT, g1, b1, (const float*)P.out, vb, nb, tid)
        }
        PHASE(4, ln_phase, P.out, (bf16_t*)(P.ws + OFF_XB), (f32x2*)(P.ws + OFF_STATS), g1, b1, vb, nb, tid)
        PHASE(5, ph_ffn_up, P, L, vb, nb, tid)
        PHASE(6, (ph_res<0, true>), P, (const bf16_t*)(P.ws + OFF_GATED), DFF, DFF, (const bf16_t*)(P.ws + OFF_WB) + WB_FFN + L * W_FFN_SZ + W_FFN_DN, 0, TT, g1, b1, (const float*)P.out, vb, nb, tid)
        PHASE(4, ln_phase, P.out, (bf16_t*)(P.ws + OFF_XB), (f32x2*)(P.ws + OFF_STATS), g2, b2, vb, nb, tid)
        PHASE(7, ph_ple, P, L, g2, b2, vb, nb, tid)
    }
}
constexpr int NPHASES = 1 + 2 * (1 + 6 + 5) + 2 * (4 + 5);

extern "C" void kernel_launch(void* const* d_in, const int* in_sizes, int n_in, void* d_out, int out_size, void* d_ws, size_t ws_size, hipStream_t stream) {
    static int grid_blocks = 0;
    if (!grid_blocks) {
        int dev = 0, cus = 0, per_cu = 0;
        hipGetDevice(&dev);
        hipDeviceGetAttribute(&cus, hipDeviceAttributeMultiprocessorCount, dev);
        hipFuncSetAttribute((const void*)mega, hipFuncAttributeMaxDynamicSharedMemorySize, LDS_BYTES);
        hipOccupancyMaxActiveBlocksPerMultiprocessor(&per_cu, (const void*)mega, NTH, LDS_BYTES);
        if (per_cu < 1) per_cu = 1;
        grid_blocks = cus * per_cu;
        if (grid_blocks > 256) grid_blocks = 256;
        if (ws_size < WS_NEED) fprintf(stderr, "kernel_launch: workspace too small: %zu < %zu\n", ws_size, (size_t)WS_NEED);
    }
    Params P{};
    P.x = (const float*)d_in[0]; P.p = (const float*)d_in[1]; P.pos = (const int*)d_in[2];
    P.mla_w_in = (const float*)d_in[3]; P.mla_q_norm = (const float*)d_in[4]; P.mla_kv_norm = (const float*)d_in[5]; P.mla_w_uq = (const float*)d_in[6];
    P.mla_w_uk = (const float*)d_in[7]; P.mla_w_uv = (const float*)d_in[8]; P.mla_w_o = (const float*)d_in[9];
    P.gla_w_in = (const float*)d_in[10]; P.gla_w_a2 = (const float*)d_in[11]; P.gla_b_a = (const float*)d_in[12]; P.gla_o_norm = (const float*)d_in[13]; P.gla_w_o = (const float*)d_in[14];
    P.ln1_g = (const float*)d_in[15]; P.ln1_b = (const float*)d_in[16]; P.ln2_g = (const float*)d_in[17]; P.ln2_b = (const float*)d_in[18];
    P.ffn_w_up = (const float*)d_in[19]; P.ffn_conv_w = (const float*)d_in[20]; P.ffn_conv_b = (const float*)d_in[21]; P.ffn_w_down = (const float*)d_in[22];
    P.ple_w_proj = (const float*)d_in[23]; P.ple_w_gate = (const float*)d_in[24]; P.ple_b_gate = (const float*)d_in[25];
    P.out = (float*)d_out; P.ws = (char*)d_ws;
    for (int i = 0; i < 32; ++i) P.invrev[i] = (1.0 / pow(10000.0, (double)(2 * i) / 64.0)) / (2.0 * M_PI);
#if MULTI_LAUNCH
    for (int ph = 0; ph < NPHASES; ++ph) {
        P.ph_lo = ph; P.ph_hi = ph + 1; P.dry = 1;
        hipLaunchKernelGGL(mega, dim3(grid_blocks), dim3(NTH), LDS_BYTES, stream, P);
    }
#else
    P.ph_lo = 0; P.ph_hi = NPHASES; P.dry = 1;
    (void)hipMemsetAsync((char*)d_ws + OFF_BAR, 0, 16384, stream);
    void* args[] = {&P};
    hipError_t e = hipLaunchCooperativeKernel((const void*)mega, dim3(grid_blocks), dim3(NTH), args, LDS_BYTES, stream);
    if (e != hipSuccess) fprintf(stderr, "cooperative launch failed: %s (grid %d)\n", hipGetErrorString(e), grid_blocks);
#endif
}
```
